# Optimizing an MI355X kernel written in HIP

```python
import math
import jax, jax.numpy as jnp
from jax import lax
import numpy as np

D_MODEL = 1024
BATCH = 2
SEQ = 8192
DEPTH = 2

D_FF = 2816
EPS = 1e-6
HG_HEADS = 4
HG_DK = 128
HG_DV = 128
D_HG = HG_HEADS * HG_DK
HG_CHUNK = 64
SSD_HEADS = 8
SSD_HEADDIM = 64
D_SSD = SSD_HEADS * SSD_HEADDIM
SSD_GROUPS = 2
SSD_STATE = 128
SSD_CONV = 4
SSD_CHUNK = 64
D_XBC = D_SSD + 2 * SSD_GROUPS * SSD_STATE
S5_GROUPS = 32
S5_GROUP_CH = 16
D_S5 = S5_GROUPS * S5_GROUP_CH
S5_STATE = 64
D_MIX = D_HG + D_SSD + D_S5
D_IN = 4 * D_HG + D_SSD + D_XBC + SSD_HEADS + D_S5

kernel_name = 'hybrid_hgrn2_ssd_s5_macaron'


def _rmsnorm(x, g):
    x32 = x.astype(jnp.float32)
    y = x32 * lax.rsqrt(jnp.mean(x32 * x32, axis=-1, keepdims=True) + EPS)
    return (y * g.astype(jnp.float32)).astype(x.dtype)


def _swiglu(x, w_gate, w_up, w_down):
    return (jax.nn.silu(x @ w_gate) * (x @ w_up)) @ w_down


def _hgrn2(q_raw, f_raw, i_raw, g_raw, lb, gnorm_w):
    out_dtype = q_raw.dtype
    bsz, seq, _ = q_raw.shape
    nc = seq // HG_CHUNK
    f32 = jnp.float32
    lb = lb.astype(f32)
    q = jax.nn.silu(q_raw.astype(f32))
    log_f = jnp.logaddexp(jnp.log(lb), jnp.log1p(-lb) + jax.nn.log_sigmoid(f_raw.astype(f32)))
    k = -jnp.expm1(log_f)
    v = i_raw.astype(f32)

    def chunks(t, d):
        return t.reshape(bsz, nc, HG_CHUNK, HG_HEADS, d).transpose(1, 0, 3, 2, 4)

    qc, kc, vc = chunks(q, HG_DK), chunks(k, HG_DK), chunks(v, HG_DV)
    bc = jnp.cumsum(chunks(log_f, HG_DK), axis=3)
    causal = jnp.tril(jnp.ones((HG_CHUNK, HG_CHUNK), dtype=bool))[:, :, None]

    def step(S, xs):
        q_, k_, v_, b_ = xs
        o_inter = jnp.einsum('bhtk,bhkv->bhtv', q_ * jnp.exp(b_), S)
        rel = b_[:, :, :, None, :] - b_[:, :, None, :, :]
        decay = jnp.exp(jnp.where(causal, rel, -jnp.inf))
        scores = jnp.einsum('bhtk,bhsk,bhtsk->bhts', q_, k_, decay)
        o_intra = jnp.einsum('bhts,bhsv->bhtv', scores, v_)
        b_last = b_[:, :, -1:, :]
        S_new = jnp.exp(b_last[:, :, 0, :])[..., None] * S + jnp.einsum(
            'bhsk,bhsv->bhkv', k_ * jnp.exp(b_last - b_), v_)
        return S_new, o_inter + o_intra

    S0 = jnp.zeros((bsz, HG_HEADS, HG_DK, HG_DV), f32)
    _, o = lax.scan(step, S0, (qc, kc, vc, bc))
    o = o.transpose(1, 0, 3, 2, 4).reshape(bsz, seq, HG_HEADS, HG_DV)
    o = o * lax.rsqrt(jnp.mean(o * o, axis=-1, keepdims=True) + EPS) * gnorm_w.astype(f32)
    o = o.reshape(bsz, seq, D_HG) * jax.nn.silu(g_raw.astype(f32))
    return o.astype(out_dtype)


def _ssd(z, xbc, dt_raw, conv_w, conv_b, dt_bias, a_log, d_skip, norm_w):
    out_dtype = z.dtype
    bsz, seq, _ = z.shape
    nc = seq // SSD_CHUNK
    hg = SSD_HEADS // SSD_GROUPS
    f32 = jnp.float32
    xbc = lax.conv_general_dilated(
        xbc.astype(f32), conv_w.astype(f32)[:, None, :], window_strides=(1,),
        padding=[(SSD_CONV - 1, 0)], dimension_numbers=('NWC', 'WIO', 'NWC'),
        feature_group_count=D_XBC)
    xbc = jax.nn.silu(xbc + conv_b.astype(f32))
    x = xbc[..., :D_SSD]
    b_in = xbc[..., D_SSD:D_SSD + SSD_GROUPS * SSD_STATE]
    c_in = xbc[..., D_SSD + SSD_GROUPS * SSD_STATE:]
    dt = jax.nn.softplus(dt_raw.astype(f32) + dt_bias.astype(f32))
    a = -jnp.exp(a_log.astype(f32)).reshape(SSD_GROUPS, hg)

    xh = x.reshape(bsz, nc, SSD_CHUNK, SSD_GROUPS, hg, SSD_HEADDIM)
    bm = b_in.reshape(bsz, nc, SSD_CHUNK, SSD_GROUPS, SSD_STATE)
    cm = c_in.reshape(bsz, nc, SSD_CHUNK, SSD_GROUPS, SSD_STATE)
    dtc = dt.reshape(bsz, nc, SSD_CHUNK, SSD_GROUPS, hg)
    a_dt = (dtc * a).transpose(0, 3, 4, 1, 2)
    a_cs = jnp.cumsum(a_dt, axis=-1)
    x_dt = xh * dtc[..., None]
    causal = jnp.tril(jnp.ones((SSD_CHUNK, SSD_CHUNK), dtype=bool))
    l_dec = jnp.exp(jnp.where(causal, a_cs[..., :, None] - a_cs[..., None, :], -jnp.inf))
    scores = jnp.einsum('bclgn,bcsgn->bgcls', cm, bm)
    y_diag = jnp.einsum('bgcls,bghcls,bcsghp->bclghp', scores, l_dec, x_dt)
    decay_states = jnp.exp(a_cs[..., -1:] - a_cs)
    states = jnp.einsum('bcsgn,bghcs,bcsghp->cbghpn', bm, decay_states, x_dt)
    chunk_decay = jnp.exp(a_cs[..., -1]).transpose(3, 0, 1, 2)

    def step(h, xs):
        dec, st = xs
        return dec[..., None, None] * h + st, h

    h0 = jnp.zeros((bsz, SSD_GROUPS, hg, SSD_HEADDIM, SSD_STATE), f32)
    _, prev = lax.scan(step, h0, (chunk_decay, states))
    y_off = jnp.einsum('bclgn,cbghpn,bghcl->bclghp', cm, prev, jnp.exp(a_cs))
    y = (y_diag + y_off).reshape(bsz, seq, D_SSD) + x * jnp.repeat(d_skip.astype(f32), SSD_HEADDIM)
    y = (y * jax.nn.silu(z.astype(f32))).reshape(bsz, seq, SSD_GROUPS, D_SSD // SSD_GROUPS)
    y = y * lax.rsqrt(jnp.mean(y * y, axis=-1, keepdims=True) + EPS)
    y = y.reshape(bsz, seq, D_SSD) * norm_w.astype(f32)
    return y.astype(out_dtype)


def _s5_combine(e1, e2):
    a1r, a1i, b1r, b1i = e1
    a2r, a2i, b2r, b2i = e2
    return (a2r * a1r - a2i * a1i,
            a2r * a1i + a2i * a1r,
            a2r * b1r - a2i * b1i + b2r,
            a2r * b1i + a2i * b1r + b2i)


def _s5(u, a_re, a_im, b_re, b_im, c_re, c_im, d_skip, log_dt, glu_w, glu_b):
    out_dtype = u.dtype
    bsz, seq, _ = u.shape
    f32 = jnp.float32
    u32 = u.astype(f32)
    ug = u32.reshape(bsz, seq, S5_GROUPS, S5_GROUP_CH)
    ar, ai = a_re.astype(f32), a_im.astype(f32)
    delta = jnp.exp(log_dt.astype(f32))[:, None]
    mag = jnp.exp(ar * delta)
    ab_re, ab_im = mag * jnp.cos(ai * delta), mag * jnp.sin(ai * delta)
    den = ar * ar + ai * ai
    nr, ni = ab_re - 1.0, ab_im
    fr = (nr * ar + ni * ai) / den
    fi = (ni * ar - nr * ai) / den
    br, bi = b_re.astype(f32), b_im.astype(f32)
    bb_re = fr[..., None] * br - fi[..., None] * bi
    bb_im = fr[..., None] * bi + fi[..., None] * br
    bu_re = jnp.einsum('blgc,gpc->blgp', ug, bb_re)
    bu_im = jnp.einsum('blgc,gpc->blgp', ug, bb_im)
    elems = (jnp.broadcast_to(ab_re, bu_re.shape), jnp.broadcast_to(ab_im, bu_im.shape), bu_re, bu_im)
    _, _, xr, xi = lax.associative_scan(_s5_combine, elems, axis=1)
    y = jnp.einsum('blgp,gcp->blgc', xr, c_re.astype(f32)) - jnp.einsum('blgp,gcp->blgc', xi, c_im.astype(f32))
    y = y.reshape(bsz, seq, D_S5) + d_skip.astype(f32) * u32
    y = jax.nn.gelu(y)
    y = y * jax.nn.sigmoid(y @ glu_w.astype(f32) + glu_b.astype(f32))
    return y.astype(out_dtype)


def _mixer(h, w_in, w_out, lb, hg_gnorm, ssd_conv_w, ssd_conv_b, ssd_dt_bias, ssd_a_log, ssd_d,
           ssd_norm, s5_a_re, s5_a_im, s5_b_re, s5_b_im, s5_c_re, s5_c_im, s5_d, s5_log_dt,
           s5_glu_w, s5_glu_b):
    sizes = (D_HG, D_HG, D_HG, D_HG, D_SSD, D_XBC, SSD_HEADS, D_S5)
    idx = [int(i) for i in np.cumsum(sizes)[:-1]]
    q, f, i, g, z, xbc, dt, u = jnp.split(h @ w_in, idx, axis=-1)
    o_a = _hgrn2(q, f, i, g, lb, hg_gnorm)
    o_b = _ssd(z, xbc, dt, ssd_conv_w, ssd_conv_b, ssd_dt_bias, ssd_a_log, ssd_d, ssd_norm)
    o_c = _s5(u, s5_a_re, s5_a_im, s5_b_re, s5_b_im, s5_c_re, s5_c_im, s5_d, s5_log_dt, s5_glu_w, s5_glu_b)
    return jnp.concatenate([o_a, o_b, o_c], axis=-1) @ w_out


def setup_inputs(seed: int = 0) -> dict:
    key = jax.random.key(seed)
    ks = jax.random.split(key, 26)
    nrm = jax.random.normal
    f32 = jnp.float32
    dt0 = jnp.exp(jax.random.uniform(ks[12], (DEPTH, SSD_HEADS), f32, math.log(1e-3), math.log(1e-1)))
    return {
        'x': nrm(ks[0], (BATCH, SEQ, D_MODEL), f32),
        'norm_g': 1.0 + 0.02 * nrm(ks[1], (DEPTH, 6, D_MODEL), f32),
        'ffn_w_gate': nrm(ks[2], (DEPTH, 2, D_MODEL, D_FF), f32) * D_MODEL ** -0.5,
        'ffn_w_up': nrm(ks[3], (DEPTH, 2, D_MODEL, D_FF), f32) * D_MODEL ** -0.5,
        'ffn_w_down': nrm(ks[4], (DEPTH, 2, D_FF, D_MODEL), f32) * D_FF ** -0.5,
        'w_in': nrm(ks[5], (DEPTH, D_MODEL, D_IN), f32) * D_MODEL ** -0.5,
        'w_out': nrm(ks[6], (DEPTH, D_MIX, D_MODEL), f32) * D_MIX ** -0.5,
        'hg_lb_logits': 0.1 * nrm(ks[7], (DEPTH, D_HG), f32),
        'hg_gnorm': 1.0 + 0.02 * nrm(ks[8], (DEPTH, HG_DV), f32),
        'ssd_conv_w': nrm(ks[9], (DEPTH, SSD_CONV, D_XBC), f32) * SSD_CONV ** -0.5,
        'ssd_conv_b': 0.01 * nrm(ks[10], (DEPTH, D_XBC), f32),
        'ssd_dt_bias': dt0 + jnp.log(-jnp.expm1(-dt0)),
        'ssd_A_log': jnp.log(jax.random.uniform(ks[11], (DEPTH, SSD_HEADS), f32, 1.0, 16.0)),
        'ssd_D': 1.0 + 0.1 * nrm(ks[13], (DEPTH, SSD_HEADS), f32),
        'ssd_norm': 1.0 + 0.02 * nrm(ks[14], (DEPTH, D_SSD), f32),
        's5_A_re': -0.5 + 0.01 * nrm(ks[15], (DEPTH, S5_GROUPS, S5_STATE), f32),
        's5_A_im': math.pi * jnp.arange(S5_STATE, dtype=f32) + 0.01 * nrm(ks[16], (DEPTH, S5_GROUPS, S5_STATE), f32),
        's5_B_re': nrm(ks[17], (DEPTH, S5_GROUPS, S5_STATE, S5_GROUP_CH), f32) * (2 * S5_GROUP_CH) ** -0.5,
        's5_B_im': nrm(ks[18], (DEPTH, S5_GROUPS, S5_STATE, S5_GROUP_CH), f32) * (2 * S5_GROUP_CH) ** -0.5,
        's5_C_re': nrm(ks[19], (DEPTH, S5_GROUPS, S5_GROUP_CH, S5_STATE), f32) * S5_STATE ** -0.5,
        's5_C_im': nrm(ks[20], (DEPTH, S5_GROUPS, S5_GROUP_CH, S5_STATE), f32) * S5_STATE ** -0.5,
        's5_D': nrm(ks[21], (DEPTH, D_S5), f32),
        's5_log_dt': jax.random.uniform(ks[22], (DEPTH, S5_GROUPS), f32, math.log(1e-3), math.log(1e-1)),
        's5_glu_w': nrm(ks[23], (DEPTH, D_S5, D_S5), f32) * D_S5 ** -0.5,
        's5_glu_b': 0.01 * nrm(ks[24], (DEPTH, D_S5), f32),
    }


def reference(x, norm_g, ffn_w_gate, ffn_w_up, ffn_w_down, w_in, w_out, hg_lb_logits, hg_gnorm,
              ssd_conv_w, ssd_conv_b, ssd_dt_bias, ssd_A_log, ssd_D, ssd_norm, s5_A_re, s5_A_im,
              s5_B_re, s5_B_im, s5_C_re, s5_C_im, s5_D, s5_log_dt, s5_glu_w, s5_glu_b):
    lb_all = jnp.cumsum(jax.nn.softmax(hg_lb_logits.astype(jnp.float32), axis=0), axis=0)
    lb_all = lb_all - lb_all[:1]
    h = x
    for l in range(DEPTH):
        g = norm_g[l]
        y = _swiglu(_rmsnorm(h, g[0]), ffn_w_gate[l, 0], ffn_w_up[l, 0], ffn_w_down[l, 0])
        h = h + 0.5 * _rmsnorm(y, g[1])
        y = _mixer(_rmsnorm(h, g[2]), w_in[l], w_out[l], lb_all[l], hg_gnorm[l],
                   ssd_conv_w[l], ssd_conv_b[l], ssd_dt_bias[l], ssd_A_log[l], ssd_D[l], ssd_norm[l],
                   s5_A_re[l], s5_A_im[l], s5_B_re[l], s5_B_im[l], s5_C_re[l], s5_C_im[l], s5_D[l],
                   s5_log_dt[l], s5_glu_w[l], s5_glu_b[l])
        h = h + _rmsnorm(y, g[3])
        y = _swiglu(_rmsnorm(h, g[4]), ffn_w_gate[l, 1], ffn_w_up[l, 1], ffn_w_down[l, 1])
        h = h + 0.5 * _rmsnorm(y, g[5])
    return h
```

```cpp
#include <hip/hip_runtime.h>
#include <hip/hip_cooperative_groups.h>
#include <cstdio>
#include <cstdint>
namespace cg = cooperative_groups;

#define LAS __attribute__((address_space(3)))
typedef unsigned short bf16_t;
typedef short bf16x8 __attribute__((ext_vector_type(8)));
typedef float f32x4 __attribute__((ext_vector_type(4)));
typedef float f32x2 __attribute__((ext_vector_type(2)));
typedef unsigned u32x4 __attribute__((ext_vector_type(4)));
typedef unsigned u32x2 __attribute__((ext_vector_type(2)));

__device__ __forceinline__ float bf2f(unsigned v) { return __builtin_bit_cast(float, v << 16); }
typedef __bf16 bf16x2_t __attribute__((ext_vector_type(2)));
__device__ __forceinline__ unsigned cvt_pk_bf16(float lo, float hi) { const f32x2 v = {lo, hi}; const bf16x2_t b = __builtin_convertvector(v, bf16x2_t); return __builtin_bit_cast(unsigned, b); }
__device__ __forceinline__ bf16_t f2bf(float f) { return (bf16_t)(cvt_pk_bf16(f, 0.f) & 0xffffu); }
__device__ __forceinline__ u32x2 pack4(f32x4 v) { u32x2 o; o.x = cvt_pk_bf16(v[0], v[1]); o.y = cvt_pk_bf16(v[2], v[3]); return o; }
__device__ __forceinline__ f32x4 unpack4(u32x2 u) { f32x4 v; v[0] = bf2f(u.x & 0xffffu); v[1] = bf2f(u.x >> 16); v[2] = bf2f(u.y & 0xffffu); v[3] = bf2f(u.y >> 16); return v; }
__device__ __forceinline__ float sigmoidf_(float x) { return 1.0f / (1.0f + __expf(-x)); }
__device__ __forceinline__ float siluf_(float x) { return x * sigmoidf_(x); }
__device__ __forceinline__ float wave_sum(float v) {
#pragma unroll
    for (int o = 1; o < 64; o <<= 1) v += __shfl_xor(v, o);
    return v;
}
__device__ __forceinline__ f32x4 mma(bf16x8 qf, bf16x8 pf, f32x4 acc) { return __builtin_amdgcn_mfma_f32_16x16x32_bf16(qf, pf, acc, 0, 0, 0); }
__device__ __forceinline__ bf16x8 ldsfrag(const LAS bf16_t* base, int row, int stride, int kk) { return *(const LAS bf16x8*)(base + row * stride + kk); }

#ifndef PG8_WGM
#define PG8_WGM 8
#endif
namespace pg8 {
constexpr int BM = 256, BK = 64, HALF = 128, HTB = HALF * BK * 2, STAGE_BYTES = 8 * HTB, NXCD = 8, WGM = PG8_WGM;
__host__ __device__ __forceinline__ int lds_byte(int r, int c) { const int st = (r >> 4) * 2 + (c >> 5), rr = r & 15, cc = c & 31, ob = rr * 64 + cc * 2; return st * 1024 + (ob ^ (((ob >> 9) & 1) << 5)); }
__host__ __device__ __forceinline__ void stage_rc(int b, int& R, int& C) { const int st = b / 1024, sb = b % 1024, swz = sb ^ (((sb >> 9) & 1) << 5); R = (st >> 1) * 16 + swz / 64; C = (st & 1) * 32 + (swz % 64) / 2; }
__host__ __device__ __forceinline__ int perm32(int rho) { const int n = rho >> 4, i = rho & 15; return 8 * (i >> 2) + 4 * n + (i & 3); }
struct Unit { int pm, pn; };
struct Gemm { const bf16_t* A; const bf16_t* Bt; int M, N, K, lda, ldb; size_t csA = 0; };
struct StaticOrder {
    int nM, nN, nwg, G, c;
    __host__ __device__ void init(int M, int N, int G_, int c_) { nM = M / BM; nN = N / BM; nwg = nM * nN; G = G_; c = c_; }
    __host__ __device__ bool next(int i, Unit& u) const {
        const long L = (long)i * G + c; if (L >= nwg) return false;
        int wgid = (int)L; { const int q = nwg / NXCD, r = nwg % NXCD, xcd = wgid % NXCD, off = wgid / NXCD; wgid = (xcd < r ? xcd * (q + 1) : r * (q + 1) + (xcd - r) * q) + off; }
        const int nig = WGM * nN, gid = wgid / nig, fm = gid * WGM, gsz = (nM - fm) < WGM ? (nM - fm) : WGM;
        u.pm = fm + ((wgid % nig) % gsz); u.pn = (wgid % nig) / gsz; return true;
    }
};
template <class Epi, bool ALIGN_EPI, bool TILED_A = false>
__device__ __forceinline__ void gemm_phase(LAS unsigned char* lds, const Gemm g, const StaticOrder& S, const Epi& E) {
    const int tid = threadIdx.x, wid = __builtin_amdgcn_readfirstlane(tid >> 6), lane = tid & 63, wr = wid >> 2, wc = wid & 3, fr = lane & 15, fq = lane >> 4;
    const int K = g.K, nt = K / BK;
    unsigned voffA[2], voffB[2];
#pragma unroll
    for (int i = 0; i < 2; ++i) { int R, C; stage_rc(tid * 16 + i * 8192, R, C);
        const int Rb = Epi::PERM ? ((R & ~31) + perm32(R & 31)) : R;
        voffA[i] = TILED_A ? (unsigned)((R >> 6) * (unsigned)g.csA + (R & 63) * 256 + C * 2) : (unsigned)(R * g.lda + C) * 2u; voffB[i] = (unsigned)(Rb * g.ldb + C) * 2u; }
    const size_t kstep = (size_t)(BK * 2);
    const size_t hA = TILED_A ? 2 * g.csA : (size_t)HALF * g.lda * 2, hB = (size_t)HALF * g.ldb * 2;
    const size_t tA = 2 * hA, tB = 2 * hB;
    const unsigned ldsw = (unsigned)wid * 1024u;
    const int aoff = lds_byte(wr * 64 + fr, fq * 8), boff = lds_byte(wc * 32 + fr, fq * 8);
#define PG8_SA(b, h) (((b) * 2 + (h)) * HTB)
#define PG8_SB(b, h) ((4 + (b) * 2 + (h)) * HTB)
#define PG8_STAGE(bufoff, gbase, voff) do { _Pragma("unroll") for (int _i = 0; _i < 2; ++_i) \
        __builtin_amdgcn_global_load_lds((const unsigned*)((const char*)(gbase) + (voff)[_i]), (LAS unsigned*)(lds + (bufoff) + ldsw + _i * 8192), 16, 0, 0); } while (0)
#define PG8_LDA(dst, b, h) do { _Pragma("unroll") for (int m = 0; m < 4; ++m) _Pragma("unroll") for (int k = 0; k < 2; ++k) dst[m][k] = *(const LAS bf16x8*)(lds + PG8_SA(b, h) + aoff + m * 2048 + k * 1024); } while (0)
#define PG8_LDB(dst, b, h) do { _Pragma("unroll") for (int n = 0; n < 2; ++n) _Pragma("unroll") for (int k = 0; k < 2; ++k) dst[n][k] = *(const LAS bf16x8*)(lds + PG8_SB(b, h) + boff + n * 2048 + k * 1024); } while (0)
#define PG8_MMA(ai, bj, At, Bt) do { __builtin_amdgcn_s_setprio(1); _Pragma("unroll") for (int m = 0; m < 4; ++m) _Pragma("unroll") for (int n = 0; n < 2; ++n) _Pragma("unroll") for (int k = 0; k < 2; ++k) \
        acc[ai][bj][m][n] = __builtin_amdgcn_mfma_f32_16x16x32_bf16(Bt[n][k], At[m][k], acc[ai][bj][m][n], 0, 0, 0); __builtin_amdgcn_s_setprio(0); } while (0)
#define PG8_WAIT_V(n) asm volatile("s_waitcnt vmcnt(" #n ")" ::: "memory")
#define PG8_WAIT_L(n) asm volatile("s_waitcnt lgkmcnt(" #n ")" ::: "memory")
#define PG8_BAR __builtin_amdgcn_s_barrier()
#define PG8_SCHED __builtin_amdgcn_sched_barrier(0)
    Unit cur, nxt; int ui = 0;
    if (!S.next(0, cur)) return;
    f32x4 acc[2][2][4][2];
#pragma unroll
    for (int a = 0; a < 2; ++a)
#pragma unroll
        for (int b = 0; b < 2; ++b)
#pragma unroll
            for (int m = 0; m < 4; ++m)
#pragma unroll
                for (int n = 0; n < 2; ++n) acc[a][b][m][n] = (f32x4){0.f, 0.f, 0.f, 0.f};
    bf16x8 At[4][2], B0[2][2], B1[2][2];
    const char* cA = (const char*)g.A + (size_t)cur.pm * tA; const char* cB = (const char*)g.Bt + (size_t)cur.pn * tB;
    PG8_STAGE(PG8_SB(0, 0), cB, voffB); PG8_STAGE(PG8_SB(0, 1), cB + hB, voffB); PG8_STAGE(PG8_SA(0, 0), cA, voffA); PG8_STAGE(PG8_SA(0, 1), cA + hA, voffA);
    if (wr == 1) PG8_BAR;
    PG8_WAIT_V(2); PG8_BAR;
    PG8_STAGE(PG8_SB(1, 0), cB + kstep, voffB); PG8_STAGE(PG8_SA(1, 0), cA + kstep, voffA); PG8_STAGE(PG8_SB(1, 1), cB + hB + kstep, voffB);
    PG8_WAIT_V(6); PG8_BAR;
    for (;;) {
        const bool has_next = S.next(ui + 1, nxt);
        const char* nA = has_next ? (const char*)g.A + (size_t)nxt.pm * tA : cA; const char* nB = has_next ? (const char*)g.Bt + (size_t)nxt.pn * tB : cB;
        for (int t = 0; t < nt; t += 2) {
            const bool last = (t == nt - 2);
            const char* a1 = TILED_A ? cA + (size_t)(t >> 1) * 16384 + 128 : cA + (size_t)(t + 1) * kstep;
            const char* a2 = last ? nA : (TILED_A ? cA + (size_t)((t + 2) >> 1) * 16384 : cA + (size_t)(t + 2) * kstep); const char* b2 = last ? nB : cB + (size_t)(t + 2) * kstep;
            const char* a3 = a2 + kstep; const char* b3 = b2 + kstep;
            PG8_LDB(B0, 0, 0); PG8_LDB(B1, 0, 1); PG8_SCHED; PG8_LDA(At, 0, 0); PG8_STAGE(PG8_SA(1, 1), a1 + hA, voffA);
            PG8_WAIT_V(8); PG8_WAIT_L(0); PG8_BAR; PG8_MMA(0, 0, At, B0); PG8_MMA(0, 1, At, B1); PG8_BAR; PG8_SCHED;
            PG8_LDA(At, 0, 1); PG8_STAGE(PG8_SB(0, 0), b2, voffB); PG8_STAGE(PG8_SB(0, 1), b2 + hB, voffB); PG8_STAGE(PG8_SA(0, 0), a2, voffA);
            PG8_WAIT_V(8); PG8_WAIT_L(0); PG8_BAR; PG8_MMA(1, 0, At, B0); PG8_MMA(1, 1, At, B1); PG8_BAR; PG8_SCHED;
            PG8_LDB(B0, 1, 0); PG8_LDB(B1, 1, 1); PG8_SCHED; PG8_LDA(At, 1, 0); PG8_STAGE(PG8_SA(0, 1), a2 + hA, voffA);
            PG8_WAIT_V(8); PG8_WAIT_L(0); PG8_BAR; PG8_MMA(0, 0, At, B0); PG8_MMA(0, 1, At, B1); PG8_BAR; PG8_SCHED;
            PG8_LDA(At, 1, 1); PG8_STAGE(PG8_SB(1, 0), b3, voffB); PG8_STAGE(PG8_SB(1, 1), b3 + hB, voffB); PG8_STAGE(PG8_SA(1, 0), a3, voffA);
            PG8_WAIT_V(8); PG8_WAIT_L(0); PG8_BAR; PG8_MMA(1, 0, At, B0); PG8_MMA(1, 1, At, B1); PG8_BAR; PG8_SCHED;
        }
        if constexpr (ALIGN_EPI) { if (wr == 0) PG8_BAR; }
        if constexpr (!Epi::AFTER_DRAIN) E(acc, cur, wr, wc, fr, fq);
        if (!has_next) break;
#pragma unroll
        for (int a = 0; a < 2; ++a)
#pragma unroll
            for (int b = 0; b < 2; ++b)
#pragma unroll
                for (int m = 0; m < 4; ++m)
#pragma unroll
                    for (int n = 0; n < 2; ++n) acc[a][b][m][n] = (f32x4){0.f, 0.f, 0.f, 0.f};
        cur = nxt; cA = nA; cB = nB; ++ui;
        if constexpr (ALIGN_EPI) { if (wr == 1) PG8_BAR; }
    }
    PG8_WAIT_V(0);
    if constexpr (!ALIGN_EPI) { if (wr == 0) PG8_BAR; }
    PG8_BAR;
    if constexpr (Epi::AFTER_DRAIN) E.fused(acc, cur, wr, wc, fr, fq, lds, wid, lane);
#undef PG8_SA
#undef PG8_SB
#undef PG8_STAGE
#undef PG8_LDA
#undef PG8_LDB
#undef PG8_MMA
#undef PG8_WAIT_V
#undef PG8_WAIT_L
#undef PG8_BAR
#undef PG8_SCHED
}

struct EpiStore {
    static constexpr bool AFTER_DRAIN = false, PERM = true;
    bf16_t* O; int ldc; const float* RS;
    __device__ __forceinline__ void operator()(const f32x4 (&acc)[2][2][4][2], const Unit& u, int wr, int wc, int fr, int fq) const {
#pragma unroll
        for (int ai = 0; ai < 2; ++ai)
#pragma unroll
            for (int m = 0; m < 4; ++m) {
                const int row = u.pm * BM + ai * HALF + wr * 64 + m * 16 + fr;
                const float rs = RS[row];
                bf16_t* rowp = O + (size_t)row * ldc + u.pn * BM + wc * 32 + 8 * fq;
#pragma unroll
                for (int bj = 0; bj < 2; ++bj) { const u32x2 lo = pack4(acc[ai][bj][m][0] * rs), hi = pack4(acc[ai][bj][m][1] * rs);
                    *(u32x4*)(rowp + bj * HALF) = (u32x4){lo.x, lo.y, hi.x, hi.y}; }
            }
    }
};
struct EpiStoreTiled {
    static constexpr bool AFTER_DRAIN = false, PERM = true;
    unsigned char* base; size_t cs; const float* RS;
    __device__ __forceinline__ void operator()(const f32x4 (&acc)[2][2][4][2], const Unit& u, int wr, int wc, int fr, int fq) const {
#pragma unroll
        for (int ai = 0; ai < 2; ++ai)
#pragma unroll
            for (int m = 0; m < 4; ++m) {
                const int row = u.pm * BM + ai * HALF + wr * 64 + m * 16 + fr;
                const float rs = RS[row];
                unsigned char* rowp = base + (size_t)(row >> 6) * cs + (size_t)(2 * u.pn) * 16384 + (row & 63) * 256 + (wc * 32 + 8 * fq) * 2;
#pragma unroll
                for (int bj = 0; bj < 2; ++bj) { const u32x2 lo = pack4(acc[ai][bj][m][0] * rs), hi = pack4(acc[ai][bj][m][1] * rs);
                    *(u32x4*)(rowp + bj * 16384) = (u32x4){lo.x, lo.y, hi.x, hi.y}; }
            }
    }
};
struct EpiSwiGLU {
    static constexpr bool AFTER_DRAIN = false, PERM = true;
    unsigned char* Hbase; size_t cs; const float* RS;
    __device__ __forceinline__ void operator()(const f32x4 (&acc)[2][2][4][2], const Unit& u, int wr, int wc, int fr, int fq) const {
#pragma unroll
        for (int ai = 0; ai < 2; ++ai)
#pragma unroll
            for (int m = 0; m < 4; ++m) {
                const int row = u.pm * BM + ai * HALF + wr * 64 + m * 16 + fr;
                const float rs = RS[row];
                unsigned char* rowp = Hbase + (size_t)(row >> 6) * cs + (size_t)u.pn * 16384 + (row & 63) * 256 + (wc * 32 + 8 * fq) * 2;
                u32x2 pk[2];
#pragma unroll
                for (int n = 0; n < 2; ++n) {
                    const f32x4 gt = acc[ai][0][m][n] * rs, up = acc[ai][1][m][n] * rs; f32x4 v;
#pragma unroll
                    for (int j = 0; j < 4; ++j) v[j] = gt[j] * __builtin_amdgcn_rcpf(1.f + __expf(-gt[j])) * up[j];
                    pk[n] = pack4(v);
                }
                *(u32x4*)rowp = (u32x4){pk[0].x, pk[0].y, pk[1].x, pk[1].y};
            }
    }
};
struct EpiGlu {
    static constexpr bool AFTER_DRAIN = false, PERM = true;
    const bf16_t* YG; const float* bias; unsigned char* Obase; int ldy; size_t cs; int ct0;
    __device__ __forceinline__ void operator()(const f32x4 (&acc)[2][2][4][2], const Unit& u, int wr, int wc, int fr, int fq) const {
#pragma unroll
        for (int ai = 0; ai < 2; ++ai)
#pragma unroll
            for (int m = 0; m < 4; ++m) {
                const size_t row = (size_t)(u.pm * BM + ai * HALF + wr * 64 + m * 16 + fr);
#pragma unroll
                for (int bj = 0; bj < 2; ++bj) {
                    const int c = u.pn * BM + bj * HALF + wc * 32 + 8 * fq;
                    const u32x4 yr = *(const u32x4*)((const unsigned char*)YG + (row >> 6) * 65536 + (size_t)(2 * u.pn + bj) * 16384 + (row & 63) * 256 + (wc * 32 + 8 * fq) * 2);
                    u32x2 pk[2];
#pragma unroll
                    for (int n = 0; n < 2; ++n) {
                        const f32x4 yg = unpack4((u32x2){n ? yr.z : yr.x, n ? yr.w : yr.y});
                        const f32x4 bb = *(const f32x4*)(bias + c + 4 * n); f32x4 v;
#pragma unroll
                        for (int j = 0; j < 4; ++j) v[j] = yg[j] * __builtin_amdgcn_rcpf(1.f + __expf(-(acc[ai][bj][m][n][j] + bb[j])));
                        pk[n] = pack4(v);
                    }
                    *(u32x4*)(Obase + (size_t)(row >> 6) * cs + (size_t)(ct0 + 2 * u.pn + bj) * 16384 + (row & 63) * 256 + (wc * 32 + 8 * fq) * 2) = (u32x4){pk[0].x, pk[0].y, pk[1].x, pk[1].y};
                }
            }
    }
};
#ifndef EPI_HB
#define EPI_HB 2
#endif
struct EpiNorm {
    static constexpr bool AFTER_DRAIN = true, PERM = true; static constexpr int HB = EPI_HB;
    const bf16_t* Hin; bf16_t* Hout; float* OutF; float* RSout; const float* gpost; float scale, eps; float* xbuf; unsigned* cnt; unsigned expect;
    __device__ __forceinline__ void operator()(const f32x4 (&)[2][2][4][2], const Unit&, int, int, int, int) const {}
    __device__ __forceinline__ void exchange(int e, const float (&ssq)[2][4], const Unit& u, int wr, int wc, int fr, int fq, LAS unsigned char* lds, float (&rs)[2][4]) const {
        LAS float* Pl = (LAS float*)lds;
        LAS float* Sl = (LAS float*)(lds + 4096);
        const int tid = threadIdx.x;
#pragma unroll
        for (int ai = 0; ai < 2; ++ai)
#pragma unroll
            for (int m = 0; m < 4; ++m) { float s = ssq[ai][m]; s += __shfl_xor(s, 16); s += __shfl_xor(s, 32); if (fq == 0) Pl[(ai * HALF + wr * 64 + m * 16 + fr) * 4 + wc] = s; }
        __syncthreads();
        float* xb = xbuf + (size_t)e * 65536 + (size_t)u.pm * 1024;
        unsigned* cw = cnt + (e * 64 + u.pm) * 64;
        if (tid < 256) { const f32x4 p = *(const LAS f32x4*)(Pl + tid * 4); __hip_atomic_store(xb + tid * 4 + u.pn, (p[0] + p[1]) + (p[2] + p[3]), __ATOMIC_RELAXED, __HIP_MEMORY_SCOPE_AGENT); }
        asm volatile("s_waitcnt vmcnt(0)" ::: "memory");
        if (tid < 256 && (tid & 63) == 0) __hip_atomic_fetch_add(cw, 1u, __ATOMIC_RELAXED, __HIP_MEMORY_SCOPE_AGENT);
        if (tid == 0) {
            unsigned sp = 0;
            while (__hip_atomic_load(cw, __ATOMIC_RELAXED, __HIP_MEMORY_SCOPE_AGENT) < 4u * expect) { __builtin_amdgcn_s_sleep(1); if (++sp > (1u << 22)) break; }
        }
        __syncthreads();
        if (tid < 256) {
            float t = 0.f;
#pragma unroll
            for (int j = 0; j < 4; ++j) t += __hip_atomic_load(xb + tid * 4 + j, __ATOMIC_RELAXED, __HIP_MEMORY_SCOPE_AGENT);
            Sl[tid] = __frsqrt_rn(t * (1.f / 1024.f) + eps);
        }
        __syncthreads();
#pragma unroll
        for (int ai = 0; ai < 2; ++ai)
#pragma unroll
            for (int m = 0; m < 4; ++m) rs[ai][m] = Sl[ai * HALF + wr * 64 + m * 16 + fr];
    }
    __device__ __forceinline__ void fused(f32x4 (&acc)[2][2][4][2], const Unit& u, int wr, int wc, int fr, int fq, LAS unsigned char* lds, int, int) const {
        float ssq[2][4], rs[2][4];
#pragma unroll
        for (int ai = 0; ai < 2; ++ai)
#pragma unroll
            for (int m = 0; m < 4; ++m) { float s = 0.f;
#pragma unroll
                for (int bj = 0; bj < 2; ++bj)
#pragma unroll
                    for (int n = 0; n < 2; ++n) { const f32x4 v = acc[ai][bj][m][n]; s += (v[0] * v[0] + v[1] * v[1]) + (v[2] * v[2] + v[3] * v[3]); }
                ssq[ai][m] = s; }
        const int col0 = u.pn * BM + wc * 32 + 8 * fq;
        u32x4 hreg[2][4][2];
#pragma unroll
        for (int ai = 0; ai < 2; ++ai)
#pragma unroll
            for (int m = 0; m < 4; ++m) { const bf16_t* hp = Hin + (size_t)(u.pm * BM + ai * HALF + wr * 64 + m * 16 + fr) * 1024 + col0;
#pragma unroll
                for (int bj = 0; bj < 2; ++bj) hreg[ai][m][bj] = *(const u32x4*)(hp + bj * HALF); }
        f32x4 gp[2][2];
#pragma unroll
        for (int bj = 0; bj < 2; ++bj)
#pragma unroll
            for (int n = 0; n < 2; ++n) gp[bj][n] = *(const f32x4*)(gpost + col0 + bj * HALF + 4 * n);
        exchange(0, ssq, u, wr, wc, fr, fq, lds, rs);
#pragma unroll
        for (int ai = 0; ai < 2; ++ai)
#pragma unroll
            for (int m = 0; m < 4; ++m) {
                const size_t roff = (size_t)(u.pm * BM + ai * HALF + wr * 64 + m * 16 + fr) * 1024 + col0;
                const float k = scale * rs[ai][m]; float s = 0.f;
#pragma unroll
                for (int bj = 0; bj < 2; ++bj) {
                    const u32x4 hr = hreg[ai][m][bj]; u32x2 pk[2];
#pragma unroll
                    for (int n = 0; n < 2; ++n) { const f32x4 v = unpack4((u32x2){n ? hr.z : hr.x, n ? hr.w : hr.y}) + (acc[ai][bj][m][n] * k) * gp[bj][n];
                        if (OutF) *(f32x4*)(OutF + roff + bj * HALF + 4 * n) = v; else pk[n] = pack4(v);
                        s += (v[0] * v[0] + v[1] * v[1]) + (v[2] * v[2] + v[3] * v[3]); }
                    if (!OutF) *(u32x4*)(Hout + roff + bj * HALF) = (u32x4){pk[0].x, pk[0].y, pk[1].x, pk[1].y};
                }
                ssq[ai][m] = s;
            }
        if (OutF) return;
        exchange(1, ssq, u, wr, wc, fr, fq, lds, rs);
        if (u.pn == 0 && wc == 0 && fq == 0) {
#pragma unroll
            for (int ai = 0; ai < 2; ++ai)
#pragma unroll
                for (int m = 0; m < 4; ++m) RSout[u.pm * BM + ai * HALF + wr * 64 + m * 16 + fr] = rs[ai][m];
        }
    }
};
}

constexpr int NTOK = 16384, SEQ = 8192, DM = 1024, DFF = 2816, DIN = 4104, DMIX = 1536, NLAYER = 2;
constexpr int PJ = 4160;
constexpr int PQ = 0, PZ = 512, PU = 1024, PF = 1536, PI = 2048, PG = 2560, PX = 3072;
constexpr size_t PT_CS = 32 * 16384 + 256;
constexpr size_t HT_CS = 22 * 16384 + 256;
constexpr int CT_Q = 0, CT_Z = 4, CT_U = 8, CT_F = 12, CT_I = 16, CT_G = 20, CT_X = 24;
constexpr float EPS = 1e-6f;
constexpr size_t MiB = (size_t)1 << 20;
constexpr size_t WS_BAR = 8192;
constexpr size_t WS_CNT = 24576;
constexpr size_t WS_LB = 0;
constexpr size_t WS_S5P = 65536, S5P_STRIDE = 458752;
constexpr size_t S5P_ABAR = 0, S5P_A64 = 16384, S5P_BBP = 32768, S5P_CM = 32768 + 262144;
constexpr size_t WS_WGU1 = 1 * MiB, WS_WD1 = 12 * MiB, WS_WGU2 = 35 * MiB / 2, WS_WD2 = 57 * MiB / 2, WS_WIN = 34 * MiB, WS_WOUT = 42 * MiB, WS_WGLU = 45 * MiB;
constexpr size_t WS_XN = 46 * MiB, WS_Y = 78 * MiB, WS_PROJ = 110 * MiB, WS_YG = 240 * MiB, WS_DT = 91 * MiB / 2;
constexpr size_t WS_S5X = 1 * MiB, WS_HGDEC = 5 * MiB, WS_SSDDEC = 6 * MiB, WS_HGS = WS_XN, WS_SSDS = WS_Y;
constexpr size_t WS_WDT = 983040;
constexpr size_t WS_XBUF = WS_Y;
constexpr size_t WS_RS = WS_YG;
constexpr size_t WS_HB2 = WS_XN;
constexpr int LDS_BYTES = 131072 + 1024;

struct Args { const float* in[25]; float* out; unsigned char* ws; int ph_lo, ph_hi, skip, pad; };
enum { I_X = 0, I_NORMG, I_WGATE, I_WUP, I_WDOWN, I_WIN, I_WOUT, I_LBLOG, I_GNORM, I_CONVW, I_CONVB, I_DTB, I_ALOG, I_SSDD, I_SSDN,
       I_S5ARE, I_S5AIM, I_S5BRE, I_S5BIM, I_S5CRE, I_S5CIM, I_S5D, I_S5LDT, I_GLUW, I_GLUB };

__device__ __forceinline__ void transpose_item(const float* W, int ldw, int K, bf16_t* WT, int k0, int ns0, int dr0, LAS float* scr, int lane, const float* gain = nullptr) {
#pragma unroll 8
    for (int i = 0; i < 32; ++i) { const int kk = 2 * i + (lane >> 5); const float gk = gain ? gain[k0 + kk] : 1.f; scr[kk * 33 + (lane & 31)] = __builtin_nontemporal_load(W + (size_t)(k0 + kk) * ldw + ns0 + (lane & 31)) * gk; }
    asm volatile("s_waitcnt lgkmcnt(0)" ::: "memory");
    const int c = lane & 7;
#pragma unroll
    for (int j = 0; j < 4; ++j) { const int n = (lane >> 3) + 8 * j; const LAS float* s = scr + (8 * c) * 33 + n;
        u32x4 o; o.x = cvt_pk_bf16(s[0 * 33], s[1 * 33]); o.y = cvt_pk_bf16(s[2 * 33], s[3 * 33]); o.z = cvt_pk_bf16(s[4 * 33], s[5 * 33]); o.w = cvt_pk_bf16(s[6 * 33], s[7 * 33]);
        *(u32x4*)(WT + (size_t)(dr0 + n) * K + k0 + 8 * c) = o; }
    asm volatile("s_waitcnt lgkmcnt(0)" ::: "memory");
}
__device__ __forceinline__ void convert_weights(LAS unsigned char* lds, const Args& a, int L) {
    const int tid = threadIdx.x, lane = tid & 63, w = tid >> 6;
    LAS float* scr = (LAS float*)(lds + w * 16384);
    const int gw = blockIdx.x * 8 + w, NGW = gridDim.x * 8;
    constexpr int I_GU = 16 * 88, I_D = 44 * 32, I_IN = 16 * 128, I_OUT = 24 * 32, I_GL = 8 * 16;
    constexpr int NIT = 4 * I_GU + 2 * I_D + I_IN + I_OUT + I_GL;
    unsigned char* ws = a.ws;
    for (int it = gw; it < NIT; it += NGW) {
        int r = it;
        if (r < 4 * I_GU) {
            const int mtx = r / I_GU, rr = r % I_GU, j = mtx >> 1, isup = mtx & 1;
            const int kb = rr / 88, nb = rr % 88, ns0 = 32 * nb;
            const float* W = (isup ? a.in[I_WUP] : a.in[I_WGATE]) + (size_t)(L * 2 + j) * DM * DFF;
            bf16_t* WT = (bf16_t*)(ws + (j ? WS_WGU2 : WS_WGU1));
            transpose_item(W, DFF, DM, WT, 64 * kb, ns0, (ns0 >> 7) * 256 + (ns0 & 127) + isup * 128, scr, lane, a.in[I_NORMG] + (size_t)(L * 6 + (j ? 4 : 0)) * DM); continue;
        }
        r -= 4 * I_GU;
        if (r < 2 * I_D) {
            const int j = r / I_D, rr = r % I_D, kb = rr / 32, nb = rr % 32;
            const float* W = a.in[I_WDOWN] + (size_t)(L * 2 + j) * DFF * DM;
            transpose_item(W, DM, DFF, (bf16_t*)(ws + (j ? WS_WD2 : WS_WD1)), 64 * kb, 32 * nb, 32 * nb, scr, lane); continue;
        }
        r -= 2 * I_D;
        if (r < I_IN) {
            const int kb = r / 128, nb = r % 128, dr0 = 32 * nb, seg = dr0 >> 9, o = dr0 & 511;
            const int src = seg == 0 ? 0 : seg == 1 ? 2048 : seg == 2 ? 3592 : seg == 3 ? 512 : seg == 4 ? 1024 : seg == 5 ? 1536 : seg == 6 ? 2560 : 3072;
            transpose_item(a.in[I_WIN] + (size_t)L * DM * DIN, DIN, DM, (bf16_t*)(ws + WS_WIN), 64 * kb, src + o, dr0, scr, lane, a.in[I_NORMG] + (size_t)(L * 6 + 2) * DM); continue;
        }
        r -= I_IN;
        if (r < I_OUT) { const int kb = r / 32, nb = r % 32;
            transpose_item(a.in[I_WOUT] + (size_t)L * DMIX * DM, DM, DMIX, (bf16_t*)(ws + WS_WOUT), 64 * kb, 32 * nb, 32 * nb, scr, lane); continue; }
        r -= I_OUT;
        { const int kb = r / 16, nb = r % 16;
          transpose_item(a.in[I_GLUW] + (size_t)L * 512 * 512, 512, 512, (bf16_t*)(ws + WS_WGLU), 64 * kb, 32 * nb, 32 * nb, scr, lane); }
    }
    for (int idx = blockIdx.x * 512 + tid; idx < 16384; idx += gridDim.x * 512) {
        const int n = idx >> 10, k = idx & 1023;
        ((bf16_t*)(ws + WS_WDT))[idx] = n < 8 ? f2bf(a.in[I_WIN][(size_t)L * DM * DIN + (size_t)k * DIN + 3584 + n] * a.in[I_NORMG][(size_t)(L * 6 + 2) * DM + k]) : (bf16_t)0;
    }
}

template <bool FIRST, bool DT, bool WXN>
__device__ __forceinline__ void rowpass(LAS unsigned char* lds, const float* hin, float* hout, const bf16_t* Y, float scale, const float* gpost, const float* gpre,
                                        bf16_t* XN, const float* winL, float* dtout) {
    const int tid = threadIdx.x, lane = tid & 63, w = tid >> 6;
    LAS f32x4* wd = (LAS f32x4*)lds;
    if (DT) {
        LAS float* wdf = (LAS float*)lds;
        for (int idx = tid; idx < 8192; idx += 512) { const int k = idx >> 3, c = idx & 7, l = (k & 255) >> 2, e = k & 3, j = k >> 8, half = c >> 2;
            wdf[((((j * 4 + e) * 2 + half) * 64 + l) << 2) + (c & 3)] = winL[(size_t)k * DIN + 3584 + c]; }
        __syncthreads();
    }
    f32x4 gp[4], gq[4];
#pragma unroll
    for (int j = 0; j < 4; ++j) { gp[j] = FIRST ? (f32x4){0.f, 0.f, 0.f, 0.f} : *(const f32x4*)(gpost + 4 * lane + 256 * j); gq[j] = WXN ? *(const f32x4*)(gpre + 4 * lane + 256 * j) : (f32x4){0.f, 0.f, 0.f, 0.f}; }
    for (int row = blockIdx.x * 8 + w; row < NTOK; row += gridDim.x * 8) {
        f32x4 hv[4];
#pragma unroll
        for (int j = 0; j < 4; ++j) hv[j] = *(const f32x4*)(hin + (size_t)row * DM + 4 * lane + 256 * j);
        if (!FIRST) {
            f32x4 yv[4]; float ss = 0.f;
#pragma unroll
            for (int j = 0; j < 4; ++j) { yv[j] = unpack4(*(const u32x2*)(Y + (size_t)row * DM + 4 * lane + 256 * j)); ss += (yv[j][0] * yv[j][0] + yv[j][1] * yv[j][1]) + (yv[j][2] * yv[j][2] + yv[j][3] * yv[j][3]); }
            const float rs = scale * __frsqrt_rn(wave_sum(ss) * (1.f / DM) + EPS);
#pragma unroll
            for (int j = 0; j < 4; ++j) hv[j] = hv[j] + (yv[j] * rs) * gp[j];
        }
#pragma unroll
        for (int j = 0; j < 4; ++j) *(f32x4*)(hout + (size_t)row * DM + 4 * lane + 256 * j) = hv[j];
        if (WXN) {
            float s2 = 0.f;
#pragma unroll
            for (int j = 0; j < 4; ++j) s2 += (hv[j][0] * hv[j][0] + hv[j][1] * hv[j][1]) + (hv[j][2] * hv[j][2] + hv[j][3] * hv[j][3]);
            const float r2 = __frsqrt_rn(wave_sum(s2) * (1.f / DM) + EPS);
            f32x4 xn[4];
#pragma unroll
            for (int j = 0; j < 4; ++j) { xn[j] = (hv[j] * r2) * gq[j]; *(u32x2*)(XN + (size_t)row * DM + 4 * lane + 256 * j) = pack4(xn[j]); }
            if (DT) {
                f32x4 d0 = {0.f, 0.f, 0.f, 0.f}, d1 = {0.f, 0.f, 0.f, 0.f};
#pragma unroll
                for (int j = 0; j < 4; ++j)
#pragma unroll
                    for (int e = 0; e < 4; ++e) { const float xv = xn[j][e]; d0 = d0 + wd[((j * 4 + e) * 2 + 0) * 64 + lane] * xv; d1 = d1 + wd[((j * 4 + e) * 2 + 1) * 64 + lane] * xv; }
                float o = 0.f;
#pragma unroll
                for (int c = 0; c < 4; ++c) { const float s0 = wave_sum(d0[c]), s1 = wave_sum(d1[c]); if (lane == c) o = s0; if (lane == 4 + c) o = s1; }
                if (lane < 8) dtout[(size_t)row * 8 + lane] = o;
            }
        }
    }
}


__device__ __forceinline__ void dt_pass(const bf16_t* XN, const bf16_t* WDT, const float* RS, float* dtout) {
    const int lane = threadIdx.x & 63, w = threadIdx.x >> 6, r = lane & 15, q = lane >> 4;
    for (int wt = w * gridDim.x + blockIdx.x; wt < NTOK / 16; wt += gridDim.x * 8) {
        const bf16_t* xp = XN + (size_t)(16 * wt + r) * DM + 8 * q; const bf16_t* wp = WDT + (size_t)r * DM + 8 * q;
        f32x4 acc = {0.f, 0.f, 0.f, 0.f};
#pragma unroll
        for (int kb = 0; kb < 4; ++kb) {
            bf16x8 xf[8], wf[8];
#pragma unroll
            for (int ks = 0; ks < 8; ++ks) { xf[ks] = *(const bf16x8*)(xp + 32 * (kb * 8 + ks)); wf[ks] = *(const bf16x8*)(wp + 32 * (kb * 8 + ks)); }
#pragma unroll
            for (int ks = 0; ks < 8; ++ks) acc = mma(wf[ks], xf[ks], acc);
        }
        if (q < 2) *(f32x4*)(dtout + (size_t)(16 * wt + r) * 8 + 4 * q) = acc * RS[16 * wt + r];
    }
}


__device__ __forceinline__ void r0_pass(const float* x, bf16_t* HBo, float* RS) {
    const int lane = threadIdx.x & 63, w = threadIdx.x >> 6;
    for (int row = (blockIdx.x * 8 + w) * 2; row < NTOK; row += gridDim.x * 16) {
        f32x4 hv[2][4];
#pragma unroll
        for (int rr = 0; rr < 2; ++rr)
#pragma unroll
            for (int j = 0; j < 4; ++j) hv[rr][j] = *(const f32x4*)(x + (size_t)(row + rr) * DM + 4 * lane + 256 * j);
#pragma unroll
        for (int rr = 0; rr < 2; ++rr) {
            float s2 = 0.f;
#pragma unroll
            for (int j = 0; j < 4; ++j) { s2 += (hv[rr][j][0] * hv[rr][j][0] + hv[rr][j][1] * hv[rr][j][1]) + (hv[rr][j][2] * hv[rr][j][2] + hv[rr][j][3] * hv[rr][j][3]);
                *(u32x2*)(HBo + (size_t)(row + rr) * DM + 4 * lane + 256 * j) = pack4(hv[rr][j]); }
            const float r2 = __frsqrt_rn(wave_sum(s2) * (1.f / DM) + EPS);
            if (lane == 0) RS[row + rr] = r2;
        }
    }
}

__device__ __forceinline__ void sincos_d(double x, double& s, double& c) {
    const double TWO_PI = 6.283185307179586476925286766559;
    x = x - TWO_PI * rint(x / TWO_PI);
    const double y = x * 0.125, y2 = y * y;
    double sy = y * (1.0 + y2 * (-1.0 / 6 + y2 * (1.0 / 120 + y2 * (-1.0 / 5040 + y2 * (1.0 / 362880 + y2 * (-1.0 / 39916800 + y2 * (1.0 / 6227020800.0)))))));
    double cy = 1.0 + y2 * (-0.5 + y2 * (1.0 / 24 + y2 * (-1.0 / 720 + y2 * (1.0 / 40320 + y2 * (-1.0 / 3628800 + y2 * (1.0 / 479001600.0))))));
#pragma unroll
    for (int i = 0; i < 3; ++i) { const double s2 = 2.0 * sy * cy, c2 = cy * cy - sy * sy; sy = s2; cy = c2; }
    s = sy; c = cy;
}
__device__ __forceinline__ void setup_params(const Args& a) {
    const int gt = blockIdx.x * 512 + threadIdx.x;
    unsigned char* ws = a.ws;
    if (gt < 512) { float* lb = (float*)(ws + WS_LB); const float a0 = a.in[I_LBLOG][gt], a1 = a.in[I_LBLOG][512 + gt]; lb[gt] = 0.f; lb[512 + gt] = 1.f / (1.f + expf(a0 - a1)); }
    if (gt < 4096) {
        const int L = gt >> 11, g = (gt >> 6) & 31, p = gt & 63, gi = (L * 32 + g) * 64 + p;
        unsigned char* base = ws + WS_S5P + (size_t)L * S5P_STRIDE;
        const double delta = exp((double)a.in[I_S5LDT][L * 32 + g]);
        const double ar = a.in[I_S5ARE][gi], ai = a.in[I_S5AIM][gi];
        const double mag = exp(ar * delta); double sn, cs; sincos_d(ai * delta, sn, cs);
        const double abr = mag * cs, abi = mag * sn, den = ar * ar + ai * ai, nr = abr - 1.0, ni = abi;
        const double fr = (nr * ar + ni * ai) / den, fi = (ni * ar - nr * ai) / den;
        double pr = abr, pi = abi;
#pragma unroll
        for (int i = 0; i < 6; ++i) { const double tr = pr * pr - pi * pi, ti = 2.0 * pr * pi; pr = tr; pi = ti; }
        ((f32x2*)(base + S5P_ABAR))[g * 64 + p] = (f32x2){(float)abr, (float)abi};
        ((f32x2*)(base + S5P_A64))[g * 64 + p] = (f32x2){(float)pr, (float)pi};
        bf16_t* bbp = (bf16_t*)(base + S5P_BBP); bf16_t* cm = (bf16_t*)(base + S5P_CM);
        for (int cc = 0; cc < 16; ++cc) {
            const double br = a.in[I_S5BRE][(size_t)gi * 16 + cc], bi = a.in[I_S5BIM][(size_t)gi * 16 + cc];
            bbp[(g * 128 + p) * 32 + cc] = f2bf((float)(fr * br - fi * bi)); bbp[(g * 128 + p) * 32 + 16 + cc] = 0;
            bbp[(g * 128 + 64 + p) * 32 + cc] = f2bf((float)(fr * bi + fi * br)); bbp[(g * 128 + 64 + p) * 32 + 16 + cc] = 0;
            const size_t ci = ((size_t)(L * 32 + g) * 16 + cc) * 64 + p;
            cm[(g * 16 + cc) * 128 + 2 * p] = f2bf(a.in[I_S5CRE][ci]); cm[(g * 16 + cc) * 128 + 2 * p + 1] = f2bf(-a.in[I_S5CIM][ci]);
        }
    }
}

#define RLX_AGENT __ATOMIC_RELAXED, __HIP_MEMORY_SCOPE_AGENT
#define XB_TMO      128
#define XB_XCNT(j)  (256  + 64 * (j))
#define XB_XSUB(j)  (1280 + 64 * (j))
#define XB_XGEN(j)  (2304 + 64 * (j))
#define XB_TOP      3328
#define XB_TOPGEN   3392
#define XCD_BAR_WORDS 3456
#define XB_SPIN_CAP (1u << 18)

__device__ __forceinline__ unsigned xb_ld(unsigned* p)              { return __hip_atomic_load(p, __ATOMIC_RELAXED, __HIP_MEMORY_SCOPE_AGENT); }
__device__ __forceinline__ unsigned xb_add(unsigned* p, unsigned v) { return __hip_atomic_fetch_add(p, v, __ATOMIC_RELAXED, __HIP_MEMORY_SCOPE_AGENT); }
__device__ __forceinline__ unsigned xb_xcc_id() { return (unsigned)__builtin_amdgcn_s_getreg((3 << 11) | 20) & 0xFu; }
#define XB_SPIN(cond, bar) do { unsigned _sp = 0; while (cond) { __builtin_amdgcn_s_sleep(1); \
    if ((++_sp & 255u) == 0u) { if (xb_ld(&(bar)[XB_TMO])) break; if (_sp > XB_SPIN_CAP) { atomicAdd(&(bar)[XB_TMO], 1u); break; } } } } while (0)

struct XcdBarrier {
    unsigned* bar; unsigned x;
    volatile LAS unsigned* st;
};

__device__ __forceinline__ XcdBarrier xcd_barrier_post(unsigned* bar, volatile LAS unsigned* st) {
    XcdBarrier b; b.bar = bar; b.x = xb_xcc_id(); b.st = st;
    if (threadIdx.x == 0) (void)xb_add(&bar[XB_XCNT(b.x)], 1u);
    return b;
}
__device__ __forceinline__ void xcd_barrier_complete(unsigned* bar, unsigned x, unsigned& nloc, unsigned& nx) {
    const unsigned G = gridDim.x * gridDim.y * gridDim.z;
    unsigned sum, cnt, mine, sp = 0u;
    for (;;) {
        sum = 0u; cnt = 0u; mine = 0u;
#pragma unroll
        for (unsigned j = 0; j < 16; ++j) { const unsigned c = xb_ld(&bar[XB_XCNT(j)]); sum += c; cnt += (c > 0u) ? 1u : 0u; mine = (j == x) ? c : mine; }
        if (sum == G) break;
        __builtin_amdgcn_s_sleep(1);
        if ((++sp & 255u) == 0u) { if (xb_ld(&bar[XB_TMO])) break; if (sp > XB_SPIN_CAP) { atomicAdd(&bar[XB_TMO], 1u); break; } }
    }
    nloc = mine > 0u ? mine : 1u; nx = cnt > 0u ? cnt : 1u;
}

__device__ __forceinline__ void xcd_barrier(const XcdBarrier& b) {
    asm volatile("s_waitcnt vmcnt(0)" ::: "memory");
    __syncthreads();
    if (threadIdx.x == 0) {
        unsigned* bar = b.bar;
        __builtin_amdgcn_s_waitcnt(0);
        unsigned nloc = b.st[0], nx = b.st[1];
        if (nloc == 0u) { xcd_barrier_complete(bar, b.x, nloc, nx); b.st[0] = nloc; b.st[1] = nx; }
        const unsigned old = xb_add(&bar[XB_XSUB(b.x)], 1u);
        const unsigned gen = old / nloc;
        if (old + 1u == (gen + 1u) * nloc) {
            __builtin_amdgcn_fence(__ATOMIC_RELEASE, "agent");
            asm volatile("s_waitcnt vmcnt(0)" ::: "memory");
            const unsigned og = xb_add(&bar[XB_TOP], 1u);
            const unsigned tg = og / nx;
            if (og + 1u == (tg + 1u) * nx) xb_add(&bar[XB_TOPGEN], 1u);
            else XB_SPIN(xb_ld(&bar[XB_TOPGEN]) == tg, bar);
            __builtin_amdgcn_fence(__ATOMIC_ACQUIRE, "agent");
            xb_add(&bar[XB_XGEN(b.x)], 1u);
            asm volatile("s_waitcnt vmcnt(0)" ::: "memory");
        } else {
            XB_SPIN(xb_ld(&bar[XB_XGEN(b.x)]) == gen, bar);
            __builtin_amdgcn_fence(__ATOMIC_ACQUIRE, "agent");
            asm volatile("s_waitcnt vmcnt(0)" ::: "memory");
        }
    }
    __syncthreads();
}


#ifndef DBG_HG
#define DBG_HG 0
#endif


__device__ __forceinline__ float rcpf_(float x) { return __builtin_amdgcn_rcpf(x); }
__device__ __forceinline__ float lo16f(unsigned u) { return __builtin_bit_cast(float, u << 16); }
__device__ __forceinline__ float hi16f(unsigned u) { return __builtin_bit_cast(float, u & 0xffff0000u); }

struct HgIn { unsigned fr[8], vr[8], qr[8]; };
struct HgLate { u32x4 sreg[4]; u32x4 greg[2]; };
template <int MODE>
__device__ __forceinline__ void hg_late(const Args& a, int it, HgLate& T) {
    const int tid = threadIdx.x, lane = tid & 63, w = tid >> 6, r = lane & 15, q = lane >> 4;
    const int b = it >> 9, h = (it >> 7) & 3, c = it & 127;
    if (MODE == 3) {
        const unsigned char* Pg = a.ws + WS_PROJ + (size_t)(b * 128 + c) * PT_CS + (size_t)(CT_G + h) * 16384;
        const bf16_t* Sg = (const bf16_t*)(a.ws + WS_HGS) + (size_t)it * 16384;
#pragma unroll
        for (int j = 0; j < 4; ++j) T.sreg[j] = __builtin_nontemporal_load((const u32x4*)(Sg + (size_t)(tid + 512 * j) * 8));
#pragma unroll
        for (int pi = 0; pi < 2; ++pi) T.greg[pi] = *(const u32x4*)(Pg + (16 * (w >> 1) + r) * 256 + (32 * (2 * (w & 1) + pi) + 8 * q) * 2);
    }
}
template <int MODE>
__device__ __forceinline__ void hg_load(const Args& a, int it, HgIn& R) {
    const int tid = threadIdx.x, lane = tid & 63, w = tid >> 6;
    const int b = it >> 9, h = (it >> 7) & 3, c = it & 127;
    const unsigned char* P = a.ws + WS_PROJ + (size_t)(b * 128 + c) * PT_CS + (size_t)h * 16384 + (8 * w) * 256 + 4 * lane;
#pragma unroll
    for (int j = 0; j < 8; ++j) { const unsigned char* pr = P + j * 256; R.fr[j] = *(const unsigned*)(pr + CT_F * 16384); R.vr[j] = *(const unsigned*)(pr + CT_I * 16384); if (MODE == 3) R.qr[j] = *(const unsigned*)(pr + CT_Q * 16384); }
}
template <int MODE>
__device__ __forceinline__ void hg_compute(LAS unsigned char* lds, const Args& a, int L, int it, const HgIn& R, const HgLate& T) {
    const int tid = threadIdx.x, lane = tid & 63, w = tid >> 6, r = lane & 15, q = lane >> 4;
    const int b = it >> 9, h = (it >> 7) & 3, c = it & 127;
    unsigned char* Pq = a.ws + WS_PROJ + (size_t)(b * 128 + c) * PT_CS + (size_t)(CT_Q + h) * 16384;
    LAS bf16_t* Qt = (LAS bf16_t*)(lds + 0);
    LAS bf16_t* Kt = (LAS bf16_t*)(lds + 17408);
    LAS bf16_t* Qi = (LAS bf16_t*)(lds + 34816);
    LAS bf16_t* VT = (LAS bf16_t*)(lds + 52224);
    LAS bf16_t* KsT = (LAS bf16_t*)(lds + 0);
    LAS bf16_t* Sc = (LAS bf16_t*)(lds + 70656);
    LAS float* tot = (LAS float*)(lds + 79872);
    LAS float* red = (LAS float*)(lds + 83968);
    LAS bf16_t* Ss = (LAS bf16_t*)(lds + 84480);
    const u32x4 (&sreg)[4] = T.sreg; const u32x4 (&greg)[2] = T.greg;
    const f32x2 lb2 = *(const f32x2*)((const float*)(a.ws + WS_LB) + L * 512 + h * 128 + 2 * lane);
    float cs[2][8], km[2][8], run[2] = {0.f, 0.f};
#pragma unroll
    for (int j = 0; j < 8; ++j)
#pragma unroll
        for (int c2 = 0; c2 < 2; ++c2) {
            const float z = c2 ? hi16f(R.fr[j]) : lo16f(R.fr[j]), lbk = c2 ? lb2.y : lb2.x;
            const float e = __expf(-z), sg = rcpf_(1.f + e), f = lbk + (1.f - lbk) * sg;
            km[c2][j] = (1.f - lbk) * e * sg;
            run[c2] += __log2f(f); cs[c2][j] = run[c2];
        }
    *(LAS f32x2*)(tot + w * 128 + 2 * lane) = (f32x2){run[0], run[1]};
    {
        u32x4 v0, v1;
#pragma unroll
        for (int j = 0; j < 4; ++j) { v0[j] = (R.vr[2 * j] & 0xffffu) | (R.vr[2 * j + 1] << 16); v1[j] = (R.vr[2 * j] >> 16) | (R.vr[2 * j + 1] & 0xffff0000u); }
        *(LAS u32x4*)(VT + (2 * lane) * 72 + 8 * w) = v0; *(LAS u32x4*)(VT + (2 * lane + 1) * 72 + 8 * w) = v1;
    }
    if (MODE == 3) {
#pragma unroll
        for (int j = 0; j < 4; ++j) { const int idx = tid + 512 * j; *(LAS u32x4*)(Ss + (idx >> 4) * 136 + (idx & 15) * 8) = sreg[j]; }
    }
    __syncthreads();
    float off[2] = {0.f, 0.f}, bmid[2] = {0.f, 0.f}, blast[2] = {0.f, 0.f};
#pragma unroll
    for (int s = 0; s < 8; ++s) { const f32x2 tv = *(const LAS f32x2*)(tot + s * 128 + 2 * lane);
        if (s < w) { off[0] += tv.x; off[1] += tv.y; } if (s < 4) { bmid[0] += tv.x; bmid[1] += tv.y; } blast[0] += tv.x; blast[1] += tv.y; }
    if (MODE == 1) {
        u32x4 k0, k1; float kv[2][8];
#pragma unroll
        for (int j = 0; j < 8; ++j)
#pragma unroll
            for (int c2 = 0; c2 < 2; ++c2) kv[c2][j] = km[c2][j] * __builtin_amdgcn_exp2f(blast[c2] - (cs[c2][j] + off[c2]));
#pragma unroll
        for (int j = 0; j < 4; ++j) { k0[j] = cvt_pk_bf16(kv[0][2 * j], kv[0][2 * j + 1]); k1[j] = cvt_pk_bf16(kv[1][2 * j], kv[1][2 * j + 1]); }
        *(LAS u32x4*)(KsT + (2 * lane) * 72 + 8 * w) = k0; *(LAS u32x4*)(KsT + (2 * lane + 1) * 72 + 8 * w) = k1;
        if (w == 0) *(f32x2*)((float*)(a.ws + WS_HGDEC) + (size_t)it * 128 + 2 * lane) = (f32x2){__builtin_amdgcn_exp2f(blast[0]), __builtin_amdgcn_exp2f(blast[1])};
        __syncthreads();
        f32x4 acc[8];
#pragma unroll
        for (int kt = 0; kt < 8; ++kt) acc[kt] = (f32x4){0.f, 0.f, 0.f, 0.f};
#pragma unroll
        for (int ks = 0; ks < 2; ++ks) {
            const bf16x8 pf = ldsfrag(VT, 16 * w + r, 72, 32 * ks + 8 * q);
#pragma unroll
            for (int kt = 0; kt < 8; ++kt) acc[kt] = mma(ldsfrag(KsT, 32 * (kt >> 1) + pg8::perm32(16 * (kt & 1) + r), 72, 32 * ks + 8 * q), pf, acc[kt]);
        }
        bf16_t* S = (bf16_t*)(a.ws + WS_HGS) + (size_t)it * 16384 + (size_t)(16 * w + r) * 128 + 8 * q;
#pragma unroll
        for (int kt = 0; kt < 8; kt += 2) { const u32x2 lo = pack4(acc[kt]), hi = pack4(acc[kt + 1]); __builtin_nontemporal_store((u32x4){lo.x, lo.y, hi.x, hi.y}, (u32x4*)(S + 16 * kt)); }
    } else {
#pragma unroll
        for (int j = 0; j < 8; ++j) {
            const int t = 8 * w + j; float qt2[2], qi2[2], kt2[2];
#pragma unroll
            for (int c2 = 0; c2 < 2; ++c2) {
                const float bt = cs[c2][j] + off[c2];
                const float qraw = c2 ? hi16f(R.qr[j]) : lo16f(R.qr[j]);
                const float qv = qraw * rcpf_(1.f + __expf(-qraw));
                qt2[c2] = qv * __builtin_amdgcn_exp2f(bt - bmid[c2]); qi2[c2] = qv * __builtin_amdgcn_exp2f(bt); kt2[c2] = km[c2][j] * __builtin_amdgcn_exp2f(bmid[c2] - bt);
            }
            *(LAS unsigned*)(Qt + t * 136 + 2 * lane) = cvt_pk_bf16(qt2[0], qt2[1]);
            *(LAS unsigned*)(Qi + t * 136 + 2 * lane) = cvt_pk_bf16(qi2[0], qi2[1]);
            *(LAS unsigned*)(Kt + t * 136 + 2 * lane) = cvt_pk_bf16(kt2[0], kt2[1]);
        }
        __syncthreads();
        const int tt = w >> 1;
#pragma unroll
        for (int i = 0; i < 2; ++i) {
            const int ts = 2 * (w & 1) + i; f32x4 acc = {0.f, 0.f, 0.f, 0.f};
            if (ts <= tt) {
#pragma unroll
                for (int ks = 0; ks < 4; ++ks) acc = mma(ldsfrag(Kt, 16 * ts + r, 136, 32 * ks + 8 * q), ldsfrag(Qt, 16 * tt + r, 136, 32 * ks + 8 * q), acc);
            }
            const int t = 16 * tt + r, s0 = 16 * ts + 4 * q;
#pragma unroll
            for (int jj = 0; jj < 4; ++jj) if (s0 + jj > t) acc[jj] = 0.f;
            *(LAS u32x2*)(Sc + t * 72 + s0) = pack4(acc);
        }
        __syncthreads();
        f32x4 o[4]; float ss = 0.f;
#pragma unroll
        for (int i = 0; i < 4; ++i) {
            const int vt = 4 * (w & 1) + i; f32x4 acc = {0.f, 0.f, 0.f, 0.f};
            const int vrow = 32 * (vt >> 1) + pg8::perm32(16 * (vt & 1) + r);
#pragma unroll
            for (int ks = 0; ks < 4; ++ks) acc = mma(ldsfrag(Ss, vrow, 136, 32 * ks + 8 * q), ldsfrag(Qi, 16 * tt + r, 136, 32 * ks + 8 * q), acc);
#pragma unroll
            for (int ks = 0; ks < 2; ++ks) acc = mma(ldsfrag(VT, vrow, 72, 32 * ks + 8 * q), ldsfrag(Sc, 16 * tt + r, 72, 32 * ks + 8 * q), acc);
            o[i] = acc; ss += (acc[0] * acc[0] + acc[1] * acc[1]) + (acc[2] * acc[2] + acc[3] * acc[3]);
        }
        ss += __shfl_xor(ss, 16); ss += __shfl_xor(ss, 32);
        if (q == 0) red[w * 16 + r] = ss;
        __syncthreads();
        const float rstd = __frsqrt_rn((red[w * 16 + r] + red[(w ^ 1) * 16 + r]) * (1.f / 128.f) + EPS);
        const int t = 16 * tt + r;
#pragma unroll
        for (int pi = 0; pi < 2; ++pi) {
            const int v0 = 32 * (2 * (w & 1) + pi) + 8 * q; u32x2 pk[2];
#pragma unroll
            for (int n = 0; n < 2; ++n) {
                const f32x4 gr = unpack4((u32x2){n ? greg[pi].z : greg[pi].x, n ? greg[pi].w : greg[pi].y});
                const f32x4 gn = *(const f32x4*)(a.in[I_GNORM] + L * 128 + v0 + 4 * n); f32x4 ov;
#pragma unroll
                for (int jj = 0; jj < 4; ++jj) ov[jj] = o[2 * pi + n][jj] * rstd * gn[jj] * gr[jj] * rcpf_(1.f + __expf(-gr[jj]));
                pk[n] = pack4(ov);
            }
            *(u32x4*)(Pq + t * 256 + v0 * 2) = (u32x4){pk[0].x, pk[0].y, pk[1].x, pk[1].y};
        }
    }
}
template <int MODE>
__device__ __forceinline__ void hg_phase(LAS unsigned char* lds, const Args& a, int L) {
    HgIn cur, nxt;
    int it = blockIdx.x;
    if (it < 1024) hg_load<MODE>(a, it, cur);
    bool first = true;
    for (; it < 1024; it += gridDim.x) {
        const int itn = it + gridDim.x;
        if (itn < 1024) hg_load<MODE>(a, itn, nxt);
        if (MODE == 1 || first) __syncthreads();
        first = false;
        HgLate late; hg_late<MODE>(a, it, late);
        hg_compute<MODE>(lds, a, L, it, cur, late);
        cur = nxt;
    }
}

struct SsdIn { unsigned xr[35]; float dtr; };
struct SsdLate { f32x2 cw[4], cb; u32x4 zreg[4]; u32x4 hreg[4][2]; };
__device__ __forceinline__ int ssd_xch(int ic, int g) { return ic < 256 ? g * 256 + ic : ic < 384 ? 512 + g * 128 + (ic - 256) : 768 + g * 128 + (ic - 384); }
__device__ __forceinline__ int ssd_toff(int ic, int g) { const int x = ssd_xch(ic, g); return (CT_X + (x >> 7)) * 16384 + (x & 127) * 2; }
template <int MODE>
__device__ __forceinline__ void ssd_load(const Args& a, int it, SsdIn& R) {
    const int tid = threadIdx.x, lane = tid & 63, w = tid >> 6;
    const int b = it >> 8, c = (it >> 1) & 127, g = it & 1;
    const size_t row0 = (size_t)b * SEQ + c * 64;
    const int ic = 2 * (tid & 255), th = tid >> 8;
    if (MODE == 3 || ic < 384) {
        const unsigned char* px = a.ws + WS_PROJ + (size_t)(b * 128 + c) * PT_CS + ssd_toff(ic, g) + (32 * th) * 256;
        const bool hist = !(c == 0 && th == 0);
        const unsigned char* ph = th ? px - 3 * 256 : px - PT_CS + 61 * 256;
#pragma unroll
        for (int i = 0; i < 3; ++i) R.xr[i] = hist ? *(const unsigned*)(ph + i * 256) : 0u;
#pragma unroll
        for (int i = 3; i < 35; ++i) R.xr[i] = *(const unsigned*)(px + (i - 3) * 256);
    }
    if (w < 4) R.dtr = ((const float*)(a.ws + WS_DT))[(row0 + lane) * 8 + g * 4 + w];
}
template <int MODE>
__device__ __forceinline__ void ssd_late(const Args& a, int L, int it, SsdLate& T) {
    const int tid = threadIdx.x, lane = tid & 63, w = tid >> 6, r = lane & 15, q = lane >> 4;
    const int b = it >> 8, c = (it >> 1) & 127, g = it & 1;
    const int ic = 2 * (tid & 255), xch = ssd_xch(ic, g);
#pragma unroll
    for (int j = 0; j < 4; ++j) T.cw[j] = *(const f32x2*)(a.in[I_CONVW] + L * 4096 + j * 1024 + xch);
    T.cb = *(const f32x2*)(a.in[I_CONVB] + L * 1024 + xch);
    if (MODE == 3) {
        const unsigned char* Pz = a.ws + WS_PROJ + (size_t)(b * 128 + c) * PT_CS + (size_t)(CT_Z + 2 * g) * 16384;
        const bf16_t* Hs = (const bf16_t*)(a.ws + WS_SSDS) + ((size_t)(b * 128 + c) * 8 + g * 4) * 8192;
#pragma unroll
        for (int hh = 0; hh < 4; ++hh) {
            T.zreg[hh] = *(const u32x4*)(Pz + (hh >> 1) * 16384 + (16 * (w >> 1) + r) * 256 + ((hh & 1) * 64 + 32 * (w & 1) + 8 * q) * 2);
#pragma unroll
            for (int i = 0; i < 2; ++i) T.hreg[hh][i] = __builtin_nontemporal_load((const u32x4*)(Hs + (size_t)hh * 8192 + (size_t)(tid + 512 * i) * 8));
        }
    }
}
template <int MODE>
__device__ __forceinline__ void ssd_compute(LAS unsigned char* lds, const Args& a, int L, int it, const SsdIn& R, const SsdLate& T) {
    const int tid = threadIdx.x, lane = tid & 63, w = tid >> 6, r = lane & 15, q = lane >> 4;
    const int b = it >> 8, c = (it >> 1) & 127, g = it & 1;
    const size_t row0 = (size_t)b * SEQ + c * 64;
    unsigned char* Pz = a.ws + WS_PROJ + (size_t)(b * 128 + c) * PT_CS + (size_t)(CT_Z + 2 * g) * 16384;
    LAS float* DTs = (LAS float*)(lds + 0);
    LAS float* ACS = (LAS float*)(lds + 1024);
    LAS float* red = (LAS float*)(lds + 2048);
    LAS bf16_t* Cm = (LAS bf16_t*)(lds + 4096);
    LAS bf16_t* Bm = (LAS bf16_t*)(lds + 21504);
    LAS bf16_t* XT = (LAS bf16_t*)(lds + 38912);
    LAS bf16_t* Mh = (LAS bf16_t*)(lds + 75776);
    LAS bf16_t* Hb1 = (LAS bf16_t*)(lds + 112640);
    LAS bf16_t* XdT = (LAS bf16_t*)(lds + 4096);
    LAS bf16_t* BT = (LAS bf16_t*)(lds + 40960);
    if (w < 4) {
        const int hd = L * 8 + g * 4 + w;
        const float dtr = R.dtr + a.in[I_DTB][hd];
        const float dtv = dtr > 20.f ? dtr : log1pf(__expf(dtr));
        float v = -dtv * __expf(a.in[I_ALOG][hd]);
#pragma unroll
        for (int o = 1; o < 64; o <<= 1) { const float n = __shfl_up(v, o); if (lane >= o) v += n; }
        DTs[w * 64 + lane] = dtv; ACS[w * 64 + lane] = v;
    }
    if (MODE == 1) __syncthreads();
    {
        const int ic = 2 * (tid & 255), th = tid >> 8;
        if (MODE == 3 || ic < 384) {
            const int hh = (ic >> 6) & 3;
            const float alast = MODE == 1 ? ACS[hh * 64 + 63] : 0.f;
#pragma unroll
            for (int j8 = 0; j8 < 4; ++j8) {
                float val[2][8];
#pragma unroll
                for (int jj = 0; jj < 8; ++jj) {
                    const int j = j8 * 8 + jj;
#pragma unroll
                    for (int c2 = 0; c2 < 2; ++c2) {
                        const float x3 = c2 ? hi16f(R.xr[j]) : lo16f(R.xr[j]), x2 = c2 ? hi16f(R.xr[j + 1]) : lo16f(R.xr[j + 1]);
                        const float x1 = c2 ? hi16f(R.xr[j + 2]) : lo16f(R.xr[j + 2]), x0 = c2 ? hi16f(R.xr[j + 3]) : lo16f(R.xr[j + 3]);
                        const float v = (c2 ? T.cw[0].y : T.cw[0].x) * x3 + (c2 ? T.cw[1].y : T.cw[1].x) * x2 + (c2 ? T.cw[2].y : T.cw[2].x) * x1 + (c2 ? T.cw[3].y : T.cw[3].x) * x0 + (c2 ? T.cb.y : T.cb.x);
                        val[c2][jj] = v * rcpf_(1.f + __expf(-v));
                    }
                }
                const int tb = 32 * th + 8 * j8;
                if (ic < 256) {
                    if (MODE == 1) {
#pragma unroll
                        for (int jj = 0; jj < 8; ++jj) { const float s = DTs[hh * 64 + tb + jj] * __expf(alast - ACS[hh * 64 + tb + jj]); val[0][jj] *= s; val[1][jj] *= s; }
                    }
                    LAS bf16_t* dst = (MODE == 1 ? XdT : XT) + ic * 72 + tb;
#pragma unroll
                    for (int c2 = 0; c2 < 2; ++c2)
                        *(LAS u32x4*)(dst + c2 * 72) = (u32x4){cvt_pk_bf16(val[c2][0], val[c2][1]), cvt_pk_bf16(val[c2][2], val[c2][3]), cvt_pk_bf16(val[c2][4], val[c2][5]), cvt_pk_bf16(val[c2][6], val[c2][7])};
                } else if (ic < 384) {
                    const int n = ic - 256;
                    if (MODE == 1) {
#pragma unroll
                        for (int c2 = 0; c2 < 2; ++c2)
                            *(LAS u32x4*)(BT + (n + c2) * 72 + tb) = (u32x4){cvt_pk_bf16(val[c2][0], val[c2][1]), cvt_pk_bf16(val[c2][2], val[c2][3]), cvt_pk_bf16(val[c2][4], val[c2][5]), cvt_pk_bf16(val[c2][6], val[c2][7])};
                    } else {
#pragma unroll
                        for (int jj = 0; jj < 8; ++jj) *(LAS unsigned*)(Bm + (tb + jj) * 136 + n) = cvt_pk_bf16(val[0][jj], val[1][jj]);
                    }
                } else {
                    const int n = ic - 384;
#pragma unroll
                    for (int jj = 0; jj < 8; ++jj) *(LAS unsigned*)(Cm + (tb + jj) * 136 + n) = cvt_pk_bf16(val[0][jj], val[1][jj]);
                }
            }
        }
    }
    __syncthreads();
    const size_t sbase = ((size_t)(b * 128 + c) * 8 + g * 4) * 8192;
    if (MODE == 1) {
        const int hh = w >> 1;
        f32x4 acc[2][8];
#pragma unroll
        for (int i = 0; i < 2; ++i)
#pragma unroll
            for (int nt = 0; nt < 8; ++nt) acc[i][nt] = (f32x4){0.f, 0.f, 0.f, 0.f};
#pragma unroll
        for (int ks = 0; ks < 2; ++ks) {
            bf16x8 pf[2];
#pragma unroll
            for (int i = 0; i < 2; ++i) pf[i] = ldsfrag(XdT, hh * 64 + 16 * (2 * (w & 1) + i) + r, 72, 32 * ks + 8 * q);
#pragma unroll
            for (int nt = 0; nt < 8; ++nt) { const bf16x8 bf = ldsfrag(BT, 32 * (nt >> 1) + pg8::perm32(16 * (nt & 1) + r), 72, 32 * ks + 8 * q);
#pragma unroll
                for (int i = 0; i < 2; ++i) acc[i][nt] = mma(bf, pf[i], acc[i][nt]); }
        }
        bf16_t* S = (bf16_t*)(a.ws + WS_SSDS) + sbase + (size_t)hh * 8192;
#pragma unroll
        for (int i = 0; i < 2; ++i)
#pragma unroll
            for (int nt = 0; nt < 8; nt += 2) { const u32x2 lo = pack4(acc[i][nt]), hi = pack4(acc[i][nt + 1]);
                __builtin_nontemporal_store((u32x4){lo.x, lo.y, hi.x, hi.y}, (u32x4*)(S + (size_t)(16 * (2 * (w & 1) + i) + r) * 128 + 16 * nt + 8 * q)); }
        if (tid < 4) ((float*)(a.ws + WS_SSDDEC))[(size_t)(b * 128 + c) * 8 + g * 4 + tid] = __expf(ACS[tid * 64 + 63]);
    } else {
        const int tl = w >> 1, l = 16 * tl + r;
#pragma unroll
        for (int i = 0; i < 2; ++i) {
            const int ts = 2 * (w & 1) + i; f32x4 acc = {0.f, 0.f, 0.f, 0.f};
            if (ts <= tl) {
#pragma unroll
                for (int ks = 0; ks < 4; ++ks) acc = mma(ldsfrag(Bm, 16 * ts + r, 136, 32 * ks + 8 * q), ldsfrag(Cm, 16 * tl + r, 136, 32 * ks + 8 * q), acc);
            }
            const int s0 = 16 * ts + 4 * q;
#pragma unroll
            for (int hh = 0; hh < 4; ++hh) {
                const float al = ACS[hh * 64 + l]; f32x4 mv;
#pragma unroll
                for (int jj = 0; jj < 4; ++jj) { const int s = s0 + jj; mv[jj] = (s <= l) ? acc[jj] * __expf(al - ACS[hh * 64 + s]) * DTs[hh * 64 + s] : 0.f; }
                *(LAS u32x2*)(Mh + (hh * 64 + l) * 72 + s0) = pack4(mv);
            }
        }
#pragma unroll
        for (int i = 0; i < 2; ++i) { const int idx = tid + 512 * i; *(LAS u32x4*)(Hb1 + (idx >> 4) * 136 + (idx & 15) * 8) = T.hreg[0][i]; }
        __syncthreads();
        f32x4 yr[4][2]; float ss = 0.f;
#pragma unroll
        for (int hh = 0; hh < 4; ++hh) {
            LAS bf16_t* Hc = (hh & 1) ? Bm : Hb1;
            if (hh < 3) { LAS bf16_t* Hn = (hh & 1) ? Hb1 : Bm;
#pragma unroll
                for (int i = 0; i < 2; ++i) { const int idx = tid + 512 * i; *(LAS u32x4*)(Hn + (idx >> 4) * 136 + (idx & 15) * 8) = T.hreg[hh + 1][i]; } }
            const float el = __expf(ACS[hh * 64 + l]), Dh = a.in[I_SSDD][L * 8 + g * 4 + hh];
#pragma unroll
            for (int i = 0; i < 2; ++i) {
                const int prow = 32 * (w & 1) + pg8::perm32(16 * i + r);
                f32x4 ad = {0.f, 0.f, 0.f, 0.f}, ao = {0.f, 0.f, 0.f, 0.f};
#pragma unroll
                for (int ks = 0; ks < 2; ++ks) ad = mma(ldsfrag(XT, hh * 64 + prow, 72, 32 * ks + 8 * q), ldsfrag(Mh, hh * 64 + 16 * tl + r, 72, 32 * ks + 8 * q), ad);
#pragma unroll
                for (int ks = 0; ks < 4; ++ks) ao = mma(ldsfrag(Hc, prow, 136, 32 * ks + 8 * q), ldsfrag(Cm, 16 * tl + r, 136, 32 * ks + 8 * q), ao);
                const int p0 = hh * 64 + 32 * (w & 1) + 8 * q + 4 * i;
                const f32x4 zr = unpack4((u32x2){i ? T.zreg[hh].z : T.zreg[hh].x, i ? T.zreg[hh].w : T.zreg[hh].y}); f32x4 yv;
#pragma unroll
                for (int jj = 0; jj < 4; ++jj) { const float xv = bf2f(XT[(p0 + jj) * 72 + l]); yv[jj] = (ad[jj] + ao[jj] * el + Dh * xv) * zr[jj] * rcpf_(1.f + __expf(-zr[jj])); }
                yr[hh][i] = yv; ss += (yv[0] * yv[0] + yv[1] * yv[1]) + (yv[2] * yv[2] + yv[3] * yv[3]);
            }
            if (hh < 3) __syncthreads();
        }
        ss += __shfl_xor(ss, 16); ss += __shfl_xor(ss, 32);
        if (q == 0) red[w * 16 + r] = ss;
        __syncthreads();
        const float rstd = __frsqrt_rn((red[w * 16 + r] + red[(w ^ 1) * 16 + r]) * (1.f / 256.f) + EPS);
#pragma unroll
        for (int hh = 0; hh < 4; ++hh) {
            const int p0 = hh * 64 + 32 * (w & 1) + 8 * q; u32x2 pk[2];
#pragma unroll
            for (int i = 0; i < 2; ++i) { const f32x4 nw = *(const f32x4*)(a.in[I_SSDN] + L * 512 + g * 256 + p0 + 4 * i); pk[i] = pack4(yr[hh][i] * rstd * nw); }
            *(u32x4*)(Pz + (hh >> 1) * 16384 + l * 256 + ((hh & 1) * 64 + 32 * (w & 1) + 8 * q) * 2) = (u32x4){pk[0].x, pk[0].y, pk[1].x, pk[1].y};
        }
    }
}
template <int MODE>
__device__ __forceinline__ void ssd_phase(LAS unsigned char* lds, const Args& a, int L) {
    if (MODE == 1) {
        SsdIn cur, nxt; SsdLate late;
        int it = blockIdx.x;
        if (it < 512) ssd_load<MODE>(a, it, cur);
        for (; it < 512; it += gridDim.x) {
            const int itn = it + gridDim.x;
            ssd_late<MODE>(a, L, it, late);
            if (itn < 512) ssd_load<MODE>(a, itn, nxt);
            __syncthreads();
            ssd_compute<MODE>(lds, a, L, it, cur, late);
            cur = nxt;
        }
    } else {
        bool first = true;
        for (int it = blockIdx.x; it < 512; it += gridDim.x) {
            SsdIn cur; SsdLate late;
            ssd_load<MODE>(a, it, cur);
            ssd_late<MODE>(a, L, it, late);
            if (first) __syncthreads();
            first = false;
            ssd_compute<MODE>(lds, a, L, it, cur, late);
        }
    }
}

struct S5In { bf16x8 uf[4]; u32x2 uv[4]; f32x2 x0; };
struct S5Par { bf16x8 bb[8], cmf[4]; f32x2 ab; f32x4 dv; };
template <int MODE>
__device__ __forceinline__ void s5_par(const Args& a, int L, int g, S5Par& Q) {
    const int lane = threadIdx.x & 63, r = lane & 15, q = lane >> 4;
    const unsigned char* pb = a.ws + WS_S5P + (size_t)L * S5P_STRIDE;
    Q.ab = ((const f32x2*)(pb + S5P_ABAR))[g * 64 + lane];
#pragma unroll
    for (int nt = 0; nt < 8; ++nt) Q.bb[nt] = *(const bf16x8*)((const bf16_t*)(pb + S5P_BBP) + (size_t)(g * 128 + 16 * nt + r) * 32 + 8 * q);
    if (MODE == 3) {
#pragma unroll
        for (int ks = 0; ks < 4; ++ks) Q.cmf[ks] = *(const bf16x8*)((const bf16_t*)(pb + S5P_CM) + (size_t)(g * 16 + r) * 128 + 32 * ks + 8 * q);
        Q.dv = *(const f32x4*)(a.in[I_S5D] + L * 512 + g * 16 + 4 * q);
    }
}
template <int MODE>
__device__ __forceinline__ void s5_load(const Args& a, int it, S5In& R) {
    const int tid = threadIdx.x, lane = tid & 63, w = tid >> 6, r = lane & 15, q = lane >> 4;
    const int b = it >> 9, c = (it >> 2) & 127, g = (it & 3) * 8 + w;
    const unsigned char* P = a.ws + WS_PROJ + (size_t)(b * 128 + c) * PT_CS + (size_t)(CT_U + (it & 3)) * 16384 + (w * 16) * 2;
#pragma unroll
    for (int sc = 0; sc < 4; ++sc) {
        R.uf[sc] = (bf16x8){0, 0, 0, 0, 0, 0, 0, 0};
        if (q < 2) R.uf[sc] = *(const bf16x8*)(P + (sc * 16 + r) * 256 + (8 * q) * 2);
        if (MODE == 3) R.uv[sc] = *(const u32x2*)(P + (sc * 16 + r) * 256 + (4 * q) * 2);
    }
    if (MODE == 3) R.x0 = *((const f32x2*)(a.ws + WS_S5X) + ((size_t)(b * 128 + c) * 32 + g) * 64 + lane);
}
template <int MODE>
__device__ __forceinline__ void s5_compute(LAS unsigned char* lds, const Args& a, int it, const S5In& R, const S5Par& Q) {
    const int tid = threadIdx.x, lane = tid & 63, w = tid >> 6, r = lane & 15, q = lane >> 4;
    const int b = it >> 9, c = (it >> 2) & 127, g = (it & 3) * 8 + w;
    const size_t row0 = (size_t)b * SEQ + c * 64;
    LAS float* BU = (LAS float*)(lds + w * 12800);
    LAS bf16_t* Xs = (LAS bf16_t*)(lds + w * 12800 + 8448);
    float xr = 0.f, xi = 0.f;
    if (MODE == 3) { xr = R.x0.x; xi = R.x0.y; }
#pragma unroll
    for (int sc = 0; sc < 4; ++sc) {
        const int t0 = sc * 16;
#pragma unroll
        for (int nt = 0; nt < 8; ++nt) { const f32x4 acc = mma(Q.bb[nt], R.uf[sc], (f32x4){0.f, 0.f, 0.f, 0.f}); *(LAS f32x4*)(BU + r * 132 + 16 * nt + 4 * q) = acc; }
        asm volatile("s_waitcnt lgkmcnt(0)" ::: "memory");
#pragma unroll
        for (int tt = 0; tt < 16; ++tt) {
            const float bur = BU[tt * 132 + lane], bui = BU[tt * 132 + 64 + lane];
            const float nr = Q.ab.x * xr - Q.ab.y * xi + bur, ni = Q.ab.x * xi + Q.ab.y * xr + bui;
            xr = nr; xi = ni;
            if (MODE == 3) *(LAS unsigned*)(Xs + tt * 136 + 2 * lane) = cvt_pk_bf16(xr, xi);
        }
        asm volatile("s_waitcnt lgkmcnt(0)" ::: "memory");
        if (MODE == 3) {
            f32x4 y = {0.f, 0.f, 0.f, 0.f};
#pragma unroll
            for (int ks = 0; ks < 4; ++ks) y = mma(Q.cmf[ks], ldsfrag(Xs, r, 136, 32 * ks + 8 * q), y);
            const f32x4 uv = unpack4(R.uv[sc]); f32x4 o;
#pragma unroll
            for (int jj = 0; jj < 4; ++jj) { const float yv = y[jj] + Q.dv[jj] * uv[jj]; o[jj] = yv * rcpf_(1.f + __expf(-1.5957691216057308f * (yv + 0.044715f * yv * yv * yv))); }
            *(u32x2*)(a.ws + WS_YG + (size_t)(b * 128 + c) * 65536 + (size_t)(it & 3) * 16384 + (t0 + r) * 256 + (w * 16 + 4 * q) * 2) = pack4(o);
        }
    }
    if (MODE == 1) *((f32x2*)(a.ws + WS_S5X) + ((size_t)(b * 128 + c) * 32 + g) * 64 + lane) = (f32x2){xr, xi};
}
template <int MODE>
__device__ __forceinline__ void s5_phase(LAS unsigned char* lds, const Args& a, int L) {
    S5In cur, nxt; S5Par Q;
    const int w = threadIdx.x >> 6;
    const bool gconst = (gridDim.x & 3) == 0;
    int it = blockIdx.x;
    if (it < 1024) { s5_par<MODE>(a, L, (it & 3) * 8 + w, Q); s5_load<MODE>(a, it, cur); }
    __syncthreads();
    for (; it < 1024; it += gridDim.x) {
        const int itn = it + gridDim.x;
        if (itn < 1024) s5_load<MODE>(a, itn, nxt);
        s5_compute<MODE>(lds, a, it, cur, Q);
        cur = nxt;
        if (!gconst && itn < 1024) s5_par<MODE>(a, L, (itn & 3) * 8 + w, Q);
    }
}

__device__ __forceinline__ void scan_phase(const Args& a, int L) {
    const int tid = threadIdx.x;
    if (tid < 128) {
        const int gi = blockIdx.x * 128 + tid, bh = gi >> 12, rem = gi & 4095, v = rem >> 5, k4 = (rem & 31) * 4;
        bf16_t* S = (bf16_t*)(a.ws + WS_HGS) + (size_t)bh * 128 * 16384 + (size_t)v * 128 + k4;
        const float* D = (const float*)(a.ws + WS_HGDEC) + (size_t)bh * 128 * 128 + k4;
        f32x4 st = {0.f, 0.f, 0.f, 0.f};
        for (int c0 = 0; c0 < 128; c0 += 8) {
            u32x2 loc[8]; f32x4 dc[8];
#pragma unroll
            for (int j = 0; j < 8; ++j) { loc[j] = __builtin_nontemporal_load((const u32x2*)(S + (size_t)(c0 + j) * 16384)); dc[j] = *(const f32x4*)(D + (size_t)(c0 + j) * 128); }
#pragma unroll
            for (int j = 0; j < 8; ++j) { __builtin_nontemporal_store(pack4(st), (u32x2*)(S + (size_t)(c0 + j) * 16384)); st = dc[j] * st + unpack4(loc[j]); }
        }
    } else if (tid < 256) {
        const int gi = blockIdx.x * 128 + (tid - 128), bhd = gi >> 11, b = bhd >> 3, hd = bhd & 7, rem = gi & 2047, p = rem >> 5, n4 = (rem & 31) * 4;
        bf16_t* S = (bf16_t*)(a.ws + WS_SSDS) + ((size_t)(b * 128) * 8 + hd) * 8192 + (size_t)p * 128 + n4;
        const float* D = (const float*)(a.ws + WS_SSDDEC) + (size_t)(b * 128) * 8 + hd;
        f32x4 st = {0.f, 0.f, 0.f, 0.f};
        for (int c0 = 0; c0 < 128; c0 += 8) {
            u32x2 loc[8]; float dc[8];
#pragma unroll
            for (int j = 0; j < 8; ++j) { loc[j] = __builtin_nontemporal_load((const u32x2*)(S + (size_t)(c0 + j) * 65536)); dc[j] = D[(size_t)(c0 + j) * 8]; }
#pragma unroll
            for (int j = 0; j < 8; ++j) { __builtin_nontemporal_store(pack4(st), (u32x2*)(S + (size_t)(c0 + j) * 65536)); st = st * dc[j] + unpack4(loc[j]); }
        }
    } else if (tid < 272) {
        const int gi = blockIdx.x * 16 + (tid - 256), b = gi >> 11, gp = gi & 2047;
        const f32x2 a64 = ((const f32x2*)(a.ws + WS_S5P + (size_t)L * S5P_STRIDE + S5P_A64))[gp];
        f32x2* X = (f32x2*)(a.ws + WS_S5X) + (size_t)(b * 128) * 2048 + gp;
        float xr = 0.f, xi = 0.f;
        for (int c0 = 0; c0 < 128; c0 += 8) {
            f32x2 e[8];
#pragma unroll
            for (int j = 0; j < 8; ++j) e[j] = X[(size_t)(c0 + j) * 2048];
#pragma unroll
            for (int j = 0; j < 8; ++j) { X[(size_t)(c0 + j) * 2048] = (f32x2){xr, xi}; const float nr = a64.x * xr - a64.y * xi + e[j].x, ni = a64.x * xi + a64.y * xr + e[j].y; xr = nr; xi = ni; }
        }
    }
}

#ifndef MK_MULTI
#define MK_MULTI 0
#endif
#ifndef GU_ALIGN
#define GU_ALIGN true
#endif
#ifndef WIN_ALIGN
#define WIN_ALIGN true
#endif
constexpr int PPL = 11;
constexpr int NPHASE = 1 + PPL * NLAYER - 1;
#define IN(k) (lo <= (k) && (k) < hi)
#define SEAM(k) do { if (IN(k) && IN((k) + 1)) xcd_barrier(xbar); } while (0)
template <int L, int J>
__device__ __forceinline__ void ffn_phases(LAS unsigned char* lds, const Args& a, const XcdBarrier& xbar, int lo, int hi) {
    constexpr int pb = 1 + PPL * L + 8 * J;
    constexpr bool lastL = (L + 1 == NLAYER), last = lastL && J == 1;
    unsigned char* ws = a.ws;
    bf16_t* HBc = (lastL && J == 1) ? (bf16_t*)(ws + WS_HB2) : (bf16_t*)a.out;
    if (IN(pb)) {
        pg8::Gemm g{HBc, (const bf16_t*)(ws + (J ? WS_WGU2 : WS_WGU1)), NTOK, 2 * DFF, DM, DM, DM}; pg8::StaticOrder S; S.init(NTOK, 2 * DFF, gridDim.x, blockIdx.x);
        pg8::EpiSwiGLU E{ws + WS_PROJ, HT_CS, (const float*)(ws + WS_RS)};
        pg8::gemm_phase<pg8::EpiSwiGLU, GU_ALIGN>(lds, g, S, E);
    }
    SEAM(pb);
    if (IN(pb + 1)) {
        pg8::Gemm g{(const bf16_t*)(ws + WS_PROJ), (const bf16_t*)(ws + (J ? WS_WD2 : WS_WD1)), NTOK, DM, DFF, 0, DFF, HT_CS}; pg8::StaticOrder S; S.init(NTOK, DM, gridDim.x, blockIdx.x);
        pg8::EpiNorm E{HBc, HBc, last ? a.out : nullptr, (float*)(ws + WS_RS), a.in[I_NORMG] + (size_t)(L * 6 + (J ? 5 : 1)) * DM, 0.5f, EPS, (float*)(ws + WS_XBUF), (unsigned*)(ws + WS_CNT), 4u * (3 * L + 2 * J + 1)};
        pg8::gemm_phase<pg8::EpiNorm, false, true>(lds, g, S, E);
    }
    SEAM(pb + 1);
}
template <int L>
__device__ __forceinline__ void layer_phases(LAS unsigned char* lds, const Args& a, const XcdBarrier& xbar, int lo, int hi) {
    constexpr int p0 = 1 + PPL * L;
    unsigned char* ws = a.ws;
    ffn_phases<L, 0>(lds, a, xbar, lo, hi);
    if (IN(p0 + 2)) {
        dt_pass((const bf16_t*)a.out, (const bf16_t*)(ws + WS_WDT), (const float*)(ws + WS_RS), (float*)(ws + WS_DT));
        pg8::Gemm g{(const bf16_t*)a.out, (const bf16_t*)(ws + WS_WIN), NTOK, 4096, DM, DM, DM}; pg8::StaticOrder S; S.init(NTOK, 4096, gridDim.x, blockIdx.x);
        pg8::EpiStoreTiled E{ws + WS_PROJ, PT_CS, (const float*)(ws + WS_RS)};
        pg8::gemm_phase<pg8::EpiStoreTiled, WIN_ALIGN>(lds, g, S, E);
    }
    SEAM(p0 + 2);
    if (IN(p0 + 3)) {
        if (!(a.skip & 1)) hg_phase<1>(lds, a, L);
        if (!(a.skip & 2)) ssd_phase<1>(lds, a, L);
        if (!(a.skip & 4)) s5_phase<1>(lds, a, L);
    }
    SEAM(p0 + 3);
    if (IN(p0 + 4)) scan_phase(a, L);
    SEAM(p0 + 4);
    if (IN(p0 + 5)) {
        if (!(a.skip & 1)) hg_phase<3>(lds, a, L);
        if (!(a.skip & 2)) ssd_phase<3>(lds, a, L);
        if (!(a.skip & 4)) s5_phase<3>(lds, a, L);
    }
    SEAM(p0 + 5);
    if (IN(p0 + 6)) {
        pg8::Gemm g{(const bf16_t*)(ws + WS_YG), (const bf16_t*)(ws + WS_WGLU), NTOK, 512, 512, 0, 512, 65536}; pg8::StaticOrder S; S.init(NTOK, 512, gridDim.x, blockIdx.x);
        pg8::EpiGlu E{(const bf16_t*)(ws + WS_YG), a.in[I_GLUB] + L * 512, ws + WS_PROJ, 512, PT_CS, CT_U};
        pg8::gemm_phase<pg8::EpiGlu, false, true>(lds, g, S, E);
    }
    SEAM(p0 + 6);
    if (IN(p0 + 7)) {
        pg8::Gemm g{(const bf16_t*)(ws + WS_PROJ), (const bf16_t*)(ws + WS_WOUT), NTOK, DM, DMIX, 0, DMIX, PT_CS}; pg8::StaticOrder S; S.init(NTOK, DM, gridDim.x, blockIdx.x);
        pg8::EpiNorm E{(const bf16_t*)a.out, (L + 1 == NLAYER) ? (bf16_t*)(ws + WS_HB2) : (bf16_t*)a.out, nullptr, (float*)(ws + WS_RS), a.in[I_NORMG] + (size_t)(L * 6 + 3) * DM, 1.0f, EPS, (float*)(ws + WS_XBUF), (unsigned*)(ws + WS_CNT), 4u * (3 * L + 2)};
        pg8::gemm_phase<pg8::EpiNorm, false, true>(lds, g, S, E);
    }
    SEAM(p0 + 7);
    ffn_phases<L, 1>(lds, a, xbar, lo, hi);
    if (L + 1 < NLAYER) {
        if (IN(p0 + 10)) convert_weights(lds, a, L + 1);
        SEAM(p0 + 10);
    }
}
__global__ void __launch_bounds__(512, 2) mega_fwd(Args a) {
    extern __shared__ __attribute__((aligned(16))) unsigned char lds_raw[];
    LAS unsigned char* lds = (LAS unsigned char*)lds_raw;
    cg::grid_group grid = cg::this_grid();
    const int lo = a.ph_lo, hi = a.ph_hi;
    volatile LAS unsigned* xst = (volatile LAS unsigned*)(lds + 131072);
    if (threadIdx.x < 4) xst[threadIdx.x] = 0u;
    __syncthreads();
    const XcdBarrier xbar = xcd_barrier_post((unsigned*)(a.ws + WS_BAR), xst);
    if (IN(0)) {
        setup_params(a);
        convert_weights(lds, a, 0);
        r0_pass(a.in[I_X], (bf16_t*)a.out, (float*)(a.ws + WS_RS));
    }
    if (lo < 0) { asm volatile("s_waitcnt vmcnt(0) lgkmcnt(0)" ::: "memory"); grid.sync(); }
    if (IN(0) && IN(1)) xcd_barrier(xbar);
    layer_phases<0>(lds, a, xbar, lo, hi);
    layer_phases<1>(lds, a, xbar, lo, hi);
}
#undef IN
#undef SEAM

extern "C" void kernel_launch(void* const* d_in, const int* in_sizes, int n_in, void* d_out, int out_size, void* d_ws, size_t ws_size, hipStream_t stream) {
    static int grid = 0;
    if (grid == 0) {
        int dev = 0, cus = 0, per_cu = 0;
        hipGetDevice(&dev);
        hipDeviceGetAttribute(&cus, hipDeviceAttributeMultiprocessorCount, dev);
        if (hipFuncSetAttribute((const void*)mega_fwd, hipFuncAttributeMaxDynamicSharedMemorySize, LDS_BYTES) != hipSuccess) fprintf(stderr, "kernel_launch: hipFuncSetAttribute failed\n");
        if (hipOccupancyMaxActiveBlocksPerMultiprocessor(&per_cu, (const void*)mega_fwd, 512, LDS_BYTES) != hipSuccess || per_cu < 1) { fprintf(stderr, "kernel_launch: occupancy query gives %d\n", per_cu); per_cu = 1; }
        (void)hipGetLastError();
        grid = cus;
        if (n_in != 25 || ws_size < 256 * MiB) fprintf(stderr, "kernel_launch: unexpected n_in %d / ws %zu\n", n_in, ws_size);
    }
    (void)hipMemsetAsync((unsigned char*)d_ws + WS_BAR, 0, 49152, stream);
    Args a{};
    for (int i = 0; i < 25; ++i) a.in[i] = (const float*)d_in[i];
    a.out = (float*)d_out; a.ws = (unsigned char*)d_ws;
#if MK_MULTI
    for (int p = 0; p < NPHASE; ++p) { a.ph_lo = p; a.ph_hi = p + 1; hipLaunchKernelGGL(mega_fwd, dim3(grid), dim3(512), LDS_BYTES, stream, a); }
#else
#ifndef DBG_PH_HI
#define DBG_PH_HI NPHASE
#endif
    a.ph_lo = 0; a.ph_hi = DBG_PH_HI;
    void* args[] = {&a};
    hipError_t e = hipLaunchCooperativeKernel((const void*)mega_fwd, dim3(grid), dim3(512), args, LDS_BYTES, stream);
    if (e != hipSuccess) fprintf(stderr, "cooperative launch failed: %s (grid %d)\n", hipGetErrorString(e), grid);
#ifdef PROBE_LIST
    { const int pl[] = PROBE_LIST;
      for (int p : pl) { a.ph_lo = p & 255; a.ph_hi = (p & 255) + 1; a.skip = p >> 8; hipLaunchKernelGGL(mega_fwd, dim3(grid), dim3(512), LDS_BYTES, stream, a); } }
#endif
#endif
}
```

```cpp
#include <hip/hip_runtime.h>
#include <hip/hip_cooperative_groups.h>
#include <cstdio>
#include <cstdint>
namespace cg = cooperative_groups;

#define LAS __attribute__((address_space(3)))
typedef unsigned short bf16_t;
typedef short bf16x8 __attribute__((ext_vector_type(8)));
typedef float f32x4 __attribute__((ext_vector_type(4)));
typedef float f32x2 __attribute__((ext_vector_type(2)));
typedef unsigned u32x4 __attribute__((ext_vector_type(4)));
typedef unsigned u32x2 __attribute__((ext_vector_type(2)));

__device__ __forceinline__ float bf2f(unsigned v) { return __builtin_bit_cast(float, v << 16); }
typedef __bf16 bf16x2_t __attribute__((ext_vector_type(2)));
__device__ __forceinline__ unsigned cvt_pk_bf16(float lo, float hi) { const f32x2 v = {lo, hi}; const bf16x2_t b = __builtin_convertvector(v, bf16x2_t); return __builtin_bit_cast(unsigned, b); }
__device__ __forceinline__ bf16_t f2bf(float f) { return (bf16_t)(cvt_pk_bf16(f, 0.f) & 0xffffu); }
__device__ __forceinline__ u32x2 pack4(f32x4 v) { u32x2 o; o.x = cvt_pk_bf16(v[0], v[1]); o.y = cvt_pk_bf16(v[2], v[3]); return o; }
__device__ __forceinline__ f32x4 unpack4(u32x2 u) { f32x4 v; v[0] = bf2f(u.x & 0xffffu); v[1] = bf2f(u.x >> 16); v[2] = bf2f(u.y & 0xffffu); v[3] = bf2f(u.y >> 16); return v; }
__device__ __forceinline__ float sigmoidf_(float x) { return 1.0f / (1.0f + __expf(-x)); }
__device__ __forceinline__ float siluf_(float x) { return x * sigmoidf_(x); }
__device__ __forceinline__ float wave_sum(float v) {
#pragma unroll
    for (int o = 1; o < 64; o <<= 1) v += __shfl_xor(v, o);
    return v;
}
__device__ __forceinline__ f32x4 mma(bf16x8 qf, bf16x8 pf, f32x4 acc) { return __builtin_amdgcn_mfma_f32_16x16x32_bf16(qf, pf, acc, 0, 0, 0); }
__device__ __forceinline__ bf16x8 ldsfrag(const LAS bf16_t* base, int row, int stride, int kk) { return *(const LAS bf16x8*)(base + row * stride + kk); }

#ifndef PG8_WGM
#define PG8_WGM 8
#endif
namespace pg8 {
constexpr int BM = 256, BK = 64, HALF = 128, HTB = HALF * BK * 2, STAGE_BYTES = 8 * HTB, NXCD = 8, WGM = PG8_WGM;
__host__ __device__ __forceinline__ int lds_byte(int r, int c) { const int st = (r >> 4) * 2 + (c >> 5), rr = r & 15, cc = c & 31, ob = rr * 64 + cc * 2; return st * 1024 + (ob ^ (((ob >> 9) & 1) << 5)); }
__host__ __device__ __forceinline__ void stage_rc(int b, int& R, int& C) { const int st = b / 1024, sb = b % 1024, swz = sb ^ (((sb >> 9) & 1) << 5); R = (st >> 1) * 16 + swz / 64; C = (st & 1) * 32 + (swz % 64) / 2; }
__host__ __device__ __forceinline__ int perm32(int rho) { const int n = rho >> 4, i = rho & 15; return 8 * (i >> 2) + 4 * n + (i & 3); }
struct Unit { int pm, pn; };
struct Gemm { const bf16_t* A; const bf16_t* Bt; int M, N, K, lda, ldb; size_t csA = 0; };
struct StaticOrder {
    int nM, nN, nwg, G, c;
    __host__ __device__ void init(int M, int N, int G_, int c_) { nM = M / BM; nN = N / BM; nwg = nM * nN; G = G_; c = c_; }
    __host__ __device__ bool next(int i, Unit& u) const {
        const long L = (long)i * G + c; if (L >= nwg) return false;
        int wgid = (int)L; { const int q = nwg / NXCD, r = nwg % NXCD, xcd = wgid % NXCD, off = wgid / NXCD; wgid = (xcd < r ? xcd * (q + 1) : r * (q + 1) + (xcd - r) * q) + off; }
        const int nig = WGM * nN, gid = wgid / nig, fm = gid * WGM, gsz = (nM - fm) < WGM ? (nM - fm) : WGM;
        u.pm = fm + ((wgid % nig) % gsz); u.pn = (wgid % nig) / gsz; return true;
    }
};
template <class Epi, bool ALIGN_EPI, bool TILED_A = false>
__device__ __forceinline__ void gemm_phase(LAS unsigned char* lds, const Gemm g, const StaticOrder& S, const Epi& E) {
    const int tid = threadIdx.x, wid = __builtin_amdgcn_readfirstlane(tid >> 6), lane = tid & 63, wr = wid >> 2, wc = wid & 3, fr = lane & 15, fq = lane >> 4;
    const int K = g.K, nt = K / BK;
    unsigned voffA[2], voffB[2];
#pragma unroll
    for (int i = 0; i < 2; ++i) { int R, C; stage_rc(tid * 16 + i * 8192, R, C);
        const int Rb = Epi::PERM ? ((R & ~31) + perm32(R & 31)) : R;
        voffA[i] = TILED_A ? (unsigned)((R >> 6) * (unsigned)g.csA + (R & 63) * 256 + C * 2) : (unsigned)(R * g.lda + C) * 2u; voffB[i] = (unsigned)(Rb * g.ldb + C) * 2u; }
    const size_t kstep = (size_t)(BK * 2);
    const size_t hA = TILED_A ? 2 * g.csA : (size_t)HALF * g.lda * 2, hB = (size_t)HALF * g.ldb * 2;
    const size_t tA = 2 * hA, tB = 2 * hB;
    const unsigned ldsw = (unsigned)wid * 1024u;
    const int aoff = lds_byte(wr * 64 + fr, fq * 8), boff = lds_byte(wc * 32 + fr, fq * 8);
#define PG8_SA(b, h) (((b) * 2 + (h)) * HTB)
#define PG8_SB(b, h) ((4 + (b) * 2 + (h)) * HTB)
#define PG8_STAGE(bufoff, gbase, voff) do { _Pragma("unroll") for (int _i = 0; _i < 2; ++_i) \
        __builtin_amdgcn_global_load_lds((const unsigned*)((const char*)(gbase) + (voff)[_i]), (LAS unsigned*)(lds + (bufoff) + ldsw + _i * 8192), 16, 0, 0); } while (0)
#define PG8_LDA(dst, b, h) do { _Pragma("unroll") for (int m = 0; m < 4; ++m) _Pragma("unroll") for (int k = 0; k < 2; ++k) dst[m][k] = *(const LAS bf16x8*)(lds + PG8_SA(b, h) + aoff + m * 2048 + k * 1024); } while (0)
#define PG8_LDB(dst, b, h) do { _Pragma("unroll") for (int n = 0; n < 2; ++n) _Pragma("unroll") for (int k = 0; k < 2; ++k) dst[n][k] = *(const LAS bf16x8*)(lds + PG8_SB(b, h) + boff + n * 2048 + k * 1024); } while (0)
#define PG8_MMA(ai, bj, At, Bt) do { __builtin_amdgcn_s_setprio(1); _Pragma("unroll") for (int m = 0; m < 4; ++m) _Pragma("unroll") for (int n = 0; n < 2; ++n) _Pragma("unroll") for (int k = 0; k < 2; ++k) \
        acc[ai][bj][m][n] = __builtin_amdgcn_mfma_f32_16x16x32_bf16(Bt[n][k], At[m][k], acc[ai][bj][m][n], 0, 0, 0); __builtin_amdgcn_s_setprio(0); } while (0)
#define PG8_WAIT_V(n) asm volatile("s_waitcnt vmcnt(" #n ")" ::: "memory")
#define PG8_WAIT_L(n) asm volatile("s_waitcnt lgkmcnt(" #n ")" ::: "memory")
#define PG8_BAR __builtin_amdgcn_s_barrier()
#define PG8_SCHED __builtin_amdgcn_sched_barrier(0)
    Unit cur, nxt; int ui = 0;
    if (!S.next(0, cur)) return;
    f32x4 acc[2][2][4][2];
#pragma unroll
    for (int a = 0; a < 2; ++a)
#pragma unroll
        for (int b = 0; b < 2; ++b)
#pragma unroll
            for (int m = 0; m < 4; ++m)
#pragma unroll
                for (int n = 0; n < 2; ++n) acc[a][b][m][n] = (f32x4){0.f, 0.f, 0.f, 0.f};
    bf16x8 At[4][2], B0[2][2], B1[2][2];
    const char* cA = (const char*)g.A + (size_t)cur.pm * tA; const char* cB = (const char*)g.Bt + (size_t)cur.pn * tB;
    PG8_STAGE(PG8_SB(0, 0), cB, voffB); PG8_STAGE(PG8_SB(0, 1), cB + hB, voffB); PG8_STAGE(PG8_SA(0, 0), cA, voffA); PG8_STAGE(PG8_SA(0, 1), cA + hA, voffA);
    if (wr == 1) PG8_BAR;
    PG8_WAIT_V(2); PG8_BAR;
    PG8_STAGE(PG8_SB(1, 0), cB + kstep, voffB); PG8_STAGE(PG8_SA(1, 0), cA + kstep, voffA); PG8_STAGE(PG8_SB(1, 1), cB + hB + kstep, voffB);
    PG8_WAIT_V(6); PG8_BAR;
    for (;;) {
        const bool has_next = S.next(ui + 1, nxt);
        const char* nA = has_next ? (const char*)g.A + (size_t)nxt.pm * tA : cA; const char* nB = has_next ? (const char*)g.Bt + (size_t)nxt.pn * tB : cB;
        for (int t = 0; t < nt; t += 2) {
            const bool last = (t == nt - 2);
            const char* a1 = TILED_A ? cA + (size_t)(t >> 1) * 16384 + 128 : cA + (size_t)(t + 1) * kstep;
            const char* a2 = last ? nA : (TILED_A ? cA + (size_t)((t + 2) >> 1) * 16384 : cA + (size_t)(t + 2) * kstep); const char* b2 = last ? nB : cB + (size_t)(t + 2) * kstep;
            const char* a3 = a2 + kstep; const char* b3 = b2 + kstep;
            PG8_LDB(B0, 0, 0); PG8_LDB(B1, 0, 1); PG8_SCHED; PG8_LDA(At, 0, 0); PG8_STAGE(PG8_SA(1, 1), a1 + hA, voffA);
            PG8_WAIT_V(8); PG8_WAIT_L(0); PG8_BAR; PG8_MMA(0, 0, At, B0); PG8_MMA(0, 1, At, B1); PG8_BAR; PG8_SCHED;
            PG8_LDA(At, 0, 1); PG8_STAGE(PG8_SB(0, 0), b2, voffB); PG8_STAGE(PG8_SB(0, 1), b2 + hB, voffB); PG8_STAGE(PG8_SA(0, 0), a2, voffA);
            PG8_WAIT_V(8); PG8_WAIT_L(0); PG8_BAR; PG8_MMA(1, 0, At, B0); PG8_MMA(1, 1, At, B1); PG8_BAR; PG8_SCHED;
            PG8_LDB(B0, 1, 0); PG8_LDB(B1, 1, 1); PG8_SCHED; PG8_LDA(At, 1, 0); PG8_STAGE(PG8_SA(0, 1), a2 + hA, voffA);
            PG8_WAIT_V(8); PG8_WAIT_L(0); PG8_BAR; PG8_MMA(0, 0, At, B0); PG8_MMA(0, 1, At, B1); PG8_BAR; PG8_SCHED;
            PG8_LDA(At, 1, 1); PG8_STAGE(PG8_SB(1, 0), b3, voffB); PG8_STAGE(PG8_SB(1, 1), b3 + hB, voffB); PG8_STAGE(PG8_SA(1, 0), a3, voffA);
            PG8_WAIT_V(8); PG8_WAIT_L(0); PG8_BAR; PG8_MMA(1, 0, At, B0); PG8_MMA(1, 1, At, B1); PG8_BAR; PG8_SCHED;
        }
        if constexpr (ALIGN_EPI) { if (wr == 0) PG8_BAR; }
        if constexpr (!Epi::AFTER_DRAIN) E(acc, cur, wr, wc, fr, fq);
        if (!has_next) break;
#pragma unroll
        for (int a = 0; a < 2; ++a)
#pragma unroll
            for (int b = 0; b < 2; ++b)
#pragma unroll
                for (int m = 0; m < 4; ++m)
#pragma unroll
                    for (int n = 0; n < 2; ++n) acc[a][b][m][n] = (f32x4){0.f, 0.f, 0.f, 0.f};
        cur = nxt; cA = nA; cB = nB; ++ui;
        if constexpr (ALIGN_EPI) { if (wr == 1) PG8_BAR; }
    }
    PG8_WAIT_V(0);
    if constexpr (!ALIGN_EPI) { if (wr == 0) PG8_BAR; }
    PG8_BAR;
    if constexpr (Epi::AFTER_DRAIN) E.fused(acc, cur, wr, wc, fr, fq, lds, wid, lane);
#undef PG8_SA
#undef PG8_SB
#undef PG8_STAGE
#undef PG8_LDA
#undef PG8_LDB
#undef PG8_MMA
#undef PG8_WAIT_V
#undef PG8_WAIT_L
#undef PG8_BAR
#undef PG8_SCHED
}

struct EpiStore {
    static constexpr bool AFTER_DRAIN = false, PERM = true;
    bf16_t* O; int ldc; const float* RS;
    __device__ __forceinline__ void operator()(const f32x4 (&acc)[2][2][4][2], const Unit& u, int wr, int wc, int fr, int fq) const {
#pragma unroll
        for (int ai = 0; ai < 2; ++ai)
#pragma unroll
            for (int m = 0; m < 4; ++m) {
                const int row = u.pm * BM + ai * HALF + wr * 64 + m * 16 + fr;
                const float rs = RS[row];
                bf16_t* rowp = O + (size_t)row * ldc + u.pn * BM + wc * 32 + 8 * fq;
#pragma unroll
                for (int bj = 0; bj < 2; ++bj) { const u32x2 lo = pack4(acc[ai][bj][m][0] * rs), hi = pack4(acc[ai][bj][m][1] * rs);
                    *(u32x4*)(rowp + bj * HALF) = (u32x4){lo.x, lo.y, hi.x, hi.y}; }
            }
    }
};
struct EpiStoreTiled {
    static constexpr bool AFTER_DRAIN = false, PERM = true;
    unsigned char* base; size_t cs; const float* RS;
    __device__ __forceinline__ void operator()(const f32x4 (&acc)[2][2][4][2], const Unit& u, int wr, int wc, int fr, int fq) const {
#pragma unroll
        for (int ai = 0; ai < 2; ++ai)
#pragma unroll
            for (int m = 0; m < 4; ++m) {
                const int row = u.pm * BM + ai * HALF + wr * 64 + m * 16 + fr;
                const float rs = RS[row];
                unsigned char* rowp = base + (size_t)(row >> 6) * cs + (size_t)(2 * u.pn) * 16384 + (row & 63) * 256 + (wc * 32 + 8 * fq) * 2;
#pragma unroll
                for (int bj = 0; bj < 2; ++bj) { const u32x2 lo = pack4(acc[ai][bj][m][0] * rs), hi = pack4(acc[ai][bj][m][1] * rs);
                    *(u32x4*)(rowp + bj * 16384) = (u32x4){lo.x, lo.y, hi.x, hi.y}; }
            }
    }
};
struct EpiSwiGLU {
    static constexpr bool AFTER_DRAIN = false, PERM = true;
    unsigned char* Hbase; size_t cs; const float* RS;
    __device__ __forceinline__ void operator()(const f32x4 (&acc)[2][2][4][2], const Unit& u, int wr, int wc, int fr, int fq) const {
#pragma unroll
        for (int ai = 0; ai < 2; ++ai)
#pragma unroll
            for (int m = 0; m < 4; ++m) {
                const int row = u.pm * BM + ai * HALF + wr * 64 + m * 16 + fr;
                const float rs = RS[row];
                unsigned char* rowp = Hbase + (size_t)(row >> 6) * cs + (size_t)u.pn * 16384 + (row & 63) * 256 + (wc * 32 + 8 * fq) * 2;
                u32x2 pk[2];
#pragma unroll
                for (int n = 0; n < 2; ++n) {
                    const f32x4 gt = acc[ai][0][m][n] * rs, up = acc[ai][1][m][n] * rs; f32x4 v;
#pragma unroll
                    for (int j = 0; j < 4; ++j) v[j] = gt[j] * __builtin_amdgcn_rcpf(1.f + __expf(-gt[j])) * up[j];
                    pk[n] = pack4(v);
                }
                *(u32x4*)rowp = (u32x4){pk[0].x, pk[0].y, pk[1].x, pk[1].y};
            }
    }
};
struct EpiGlu {
    static constexpr bool AFTER_DRAIN = false, PERM = true;
    const bf16_t* YG; const float* bias; unsigned char* Obase; int ldy; size_t cs; int ct0;
    __device__ __forceinline__ void operator()(const f32x4 (&acc)[2][2][4][2], const Unit& u, int wr, int wc, int fr, int fq) const {
#pragma unroll
        for (int ai = 0; ai < 2; ++ai)
#pragma unroll
            for (int m = 0; m < 4; ++m) {
                const size_t row = (size_t)(u.pm * BM + ai * HALF + wr * 64 + m * 16 + fr);
#pragma unroll
                for (int bj = 0; bj < 2; ++bj) {
                    const int c = u.pn * BM + bj * HALF + wc * 32 + 8 * fq;
                    const u32x4 yr = *(const u32x4*)((const unsigned char*)YG + (row >> 6) * 65536 + (size_t)(2 * u.pn + bj) * 16384 + (row & 63) * 256 + (wc * 32 + 8 * fq) * 2);
                    u32x2 pk[2];
#pragma unroll
                    for (int n = 0; n < 2; ++n) {
                        const f32x4 yg = unpack4((u32x2){n ? yr.z : yr.x, n ? yr.w : yr.y});
                        const f32x4 bb = *(const f32x4*)(bias + c + 4 * n); f32x4 v;
#pragma unroll
                        for (int j = 0; j < 4; ++j) v[j] = yg[j] * __builtin_amdgcn_rcpf(1.f + __expf(-(acc[ai][bj][m][n][j] + bb[j])));
                        pk[n] = pack4(v);
                    }
                    *(u32x4*)(Obase + (size_t)(row >> 6) * cs + (size_t)(ct0 + 2 * u.pn + bj) * 16384 + (row & 63) * 256 + (wc * 32 + 8 * fq) * 2) = (u32x4){pk[0].x, pk[0].y, pk[1].x, pk[1].y};
                }
            }
    }
};
#ifndef EPI_HB
#define EPI_HB 2
#endif
struct EpiNorm {
    static constexpr bool AFTER_DRAIN = true, PERM = true; static constexpr int HB = EPI_HB;
    const bf16_t* Hin; bf16_t* Hout; float* OutF; float* RSout; const float* gpost; float scale, eps; float* xbuf; unsigned* cnt; unsigned expect;
    __device__ __forceinline__ void operator()(const f32x4 (&)[2][2][4][2], const Unit&, int, int, int, int) const {}
    __device__ __forceinline__ void exchange(int e, const float (&ssq)[2][4], const Unit& u, int wr, int wc, int fr, int fq, LAS unsigned char* lds, float (&rs)[2][4]) const {
        LAS float* Pl = (LAS float*)lds;
        LAS float* Sl = (LAS float*)(lds + 4096);
        const int tid = threadIdx.x;
#pragma unroll
        for (int ai = 0; ai < 2; ++ai)
#pragma unroll
            for (int m = 0; m < 4; ++m) { float s = ssq[ai][m]; s += __shfl_xor(s, 16); s += __shfl_xor(s, 32); if (fq == 0) Pl[(ai * HALF + wr * 64 + m * 16 + fr) * 4 + wc] = s; }
        __syncthreads();
        float* xb = xbuf + (size_t)e * 65536 + (size_t)u.pm * 1024;
        unsigned* cw = cnt + (e * 64 + u.pm) * 64;
        if (tid < 256) { const f32x4 p = *(const LAS f32x4*)(Pl + tid * 4); __hip_atomic_store(xb + tid * 4 + u.pn, (p[0] + p[1]) + (p[2] + p[3]), __ATOMIC_RELAXED, __HIP_MEMORY_SCOPE_AGENT); }
        asm volatile("s_waitcnt vmcnt(0)" ::: "memory");
        __syncthreads();
        if (tid == 0) {
            __hip_atomic_fetch_add(cw, 1u, __ATOMIC_RELAXED, __HIP_MEMORY_SCOPE_AGENT);
            unsigned sp = 0;
            while (__hip_atomic_load(cw, __ATOMIC_RELAXED, __HIP_MEMORY_SCOPE_AGENT) < expect) { __builtin_amdgcn_s_sleep(1); if (++sp > (1u << 22)) break; }
        }
        __syncthreads();
        if (tid < 256) {
            float t = 0.f;
#pragma unroll
            for (int j = 0; j < 4; ++j) t += __hip_atomic_load(xb + tid * 4 + j, __ATOMIC_RELAXED, __HIP_MEMORY_SCOPE_AGENT);
            Sl[tid] = __frsqrt_rn(t * (1.f / 1024.f) + eps);
        }
        __syncthreads();
#pragma unroll
        for (int ai = 0; ai < 2; ++ai)
#pragma unroll
            for (int m = 0; m < 4; ++m) rs[ai][m] = Sl[ai * HALF + wr * 64 + m * 16 + fr];
    }
    __device__ __forceinline__ void fused(f32x4 (&acc)[2][2][4][2], const Unit& u, int wr, int wc, int fr, int fq, LAS unsigned char* lds, int, int) const {
        float ssq[2][4], rs[2][4];
#pragma unroll
        for (int ai = 0; ai < 2; ++ai)
#pragma unroll
            for (int m = 0; m < 4; ++m) { float s = 0.f;
#pragma unroll
                for (int bj = 0; bj < 2; ++bj)
#pragma unroll
                    for (int n = 0; n < 2; ++n) { const f32x4 v = acc[ai][bj][m][n]; s += (v[0] * v[0] + v[1] * v[1]) + (v[2] * v[2] + v[3] * v[3]); }
                ssq[ai][m] = s; }
        const int col0 = u.pn * BM + wc * 32 + 8 * fq;
        u32x4 hreg[2][4][2];
#pragma unroll
        for (int ai = 0; ai < 2; ++ai)
#pragma unroll
            for (int m = 0; m < 4; ++m) { const bf16_t* hp = Hin + (size_t)(u.pm * BM + ai * HALF + wr * 64 + m * 16 + fr) * 1024 + col0;
#pragma unroll
                for (int bj = 0; bj < 2; ++bj) hreg[ai][m][bj] = *(const u32x4*)(hp + bj * HALF); }
        f32x4 gp[2][2];
#pragma unroll
        for (int bj = 0; bj < 2; ++bj)
#pragma unroll
            for (int n = 0; n < 2; ++n) gp[bj][n] = *(const f32x4*)(gpost + col0 + bj * HALF + 4 * n);
        exchange(0, ssq, u, wr, wc, fr, fq, lds, rs);
#pragma unroll
        for (int ai = 0; ai < 2; ++ai)
#pragma unroll
            for (int m = 0; m < 4; ++m) {
                const size_t roff = (size_t)(u.pm * BM + ai * HALF + wr * 64 + m * 16 + fr) * 1024 + col0;
                const float k = scale * rs[ai][m]; float s = 0.f;
#pragma unroll
                for (int bj = 0; bj < 2; ++bj) {
                    const u32x4 hr = hreg[ai][m][bj]; u32x2 pk[2];
#pragma unroll
                    for (int n = 0; n < 2; ++n) { const f32x4 v = unpack4((u32x2){n ? hr.z : hr.x, n ? hr.w : hr.y}) + (acc[ai][bj][m][n] * k) * gp[bj][n];
                        if (OutF) *(f32x4*)(OutF + roff + bj * HALF + 4 * n) = v; else pk[n] = pack4(v);
                        s += (v[0] * v[0] + v[1] * v[1]) + (v[2] * v[2] + v[3] * v[3]); }
                    if (!OutF) *(u32x4*)(Hout + roff + bj * HALF) = (u32x4){pk[0].x, pk[0].y, pk[1].x, pk[1].y};
                }
                ssq[ai][m] = s;
            }
        if (OutF) return;
        exchange(1, ssq, u, wr, wc, fr, fq, lds, rs);
        if (u.pn == 0 && wc == 0 && fq == 0) {
#pragma unroll
            for (int ai = 0; ai < 2; ++ai)
#pragma unroll
                for (int m = 0; m < 4; ++m) RSout[u.pm * BM + ai * HALF + wr * 64 + m * 16 + fr] = rs[ai][m];
        }
    }
};
}

constexpr int NTOK = 16384, SEQ = 8192, DM = 1024, DFF = 2816, DIN = 4104, DMIX = 1536, NLAYER = 2;
constexpr int PJ = 4160;
constexpr int PQ = 0, PZ = 512, PU = 1024, PF = 1536, PI = 2048, PG = 2560, PX = 3072;
constexpr size_t PT_CS = 32 * 16384 + 256;
constexpr size_t HT_CS = 22 * 16384 + 256;
constexpr int CT_Q = 0, CT_Z = 4, CT_U = 8, CT_F = 12, CT_I = 16, CT_G = 20, CT_X = 24;
constexpr float EPS = 1e-6f;
constexpr size_t MiB = (size_t)1 << 20;
constexpr size_t WS_BAR = 8192;
constexpr size_t WS_CNT = 24576;
constexpr size_t WS_LB = 0;
constexpr size_t WS_S5P = 65536, S5P_STRIDE = 458752;
constexpr size_t S5P_ABAR = 0, S5P_A64 = 16384, S5P_BBP = 32768, S5P_CM = 32768 + 262144;
constexpr size_t WS_WGU1 = 1 * MiB, WS_WD1 = 12 * MiB, WS_WGU2 = 35 * MiB / 2, WS_WD2 = 57 * MiB / 2, WS_WIN = 34 * MiB, WS_WOUT = 42 * MiB, WS_WGLU = 45 * MiB;
constexpr size_t WS_XN = 46 * MiB, WS_Y = 78 * MiB, WS_PROJ = 110 * MiB, WS_YG = 240 * MiB, WS_DT = 91 * MiB / 2;
constexpr size_t WS_S5X = 1 * MiB, WS_HGDEC = 5 * MiB, WS_SSDDEC = 6 * MiB, WS_HGS = WS_XN, WS_SSDS = WS_Y;
constexpr size_t WS_WDT = 983040;
constexpr size_t WS_XBUF = WS_Y;
constexpr size_t WS_RS = WS_YG;
constexpr size_t WS_HB2 = WS_XN;
constexpr int LDS_BYTES = 131072 + 1024;

struct Args { const float* in[25]; float* out; unsigned char* ws; int ph_lo, ph_hi, skip, pad; };
enum { I_X = 0, I_NORMG, I_WGATE, I_WUP, I_WDOWN, I_WIN, I_WOUT, I_LBLOG, I_GNORM, I_CONVW, I_CONVB, I_DTB, I_ALOG, I_SSDD, I_SSDN,
       I_S5ARE, I_S5AIM, I_S5BRE, I_S5BIM, I_S5CRE, I_S5CIM, I_S5D, I_S5LDT, I_GLUW, I_GLUB };

__device__ __forceinline__ void transpose_item(const float* W, int ldw, int K, bf16_t* WT, int k0, int ns0, int dr0, LAS float* scr, int lane, const float* gain = nullptr) {
#pragma unroll 8
    for (int i = 0; i < 32; ++i) { const int kk = 2 * i + (lane >> 5); const float gk = gain ? gain[k0 + kk] : 1.f; scr[kk * 33 + (lane & 31)] = __builtin_nontemporal_load(W + (size_t)(k0 + kk) * ldw + ns0 + (lane & 31)) * gk; }
    asm volatile("s_waitcnt lgkmcnt(0)" ::: "memory");
    const int c = lane & 7;
#pragma unroll
    for (int j = 0; j < 4; ++j) { const int n = (lane >> 3) + 8 * j; const LAS float* s = scr + (8 * c) * 33 + n;
        u32x4 o; o.x = cvt_pk_bf16(s[0 * 33], s[1 * 33]); o.y = cvt_pk_bf16(s[2 * 33], s[3 * 33]); o.z = cvt_pk_bf16(s[4 * 33], s[5 * 33]); o.w = cvt_pk_bf16(s[6 * 33], s[7 * 33]);
        *(u32x4*)(WT + (size_t)(dr0 + n) * K + k0 + 8 * c) = o; }
    asm volatile("s_waitcnt lgkmcnt(0)" ::: "memory");
}
__device__ __forceinline__ void convert_weights(LAS unsigned char* lds, const Args& a, int L) {
    const int tid = threadIdx.x, lane = tid & 63, w = tid >> 6;
    LAS float* scr = (LAS float*)(lds + w * 16384);
    const int gw = blockIdx.x * 8 + w, NGW = gridDim.x * 8;
    constexpr int I_GU = 16 * 88, I_D = 44 * 32, I_IN = 16 * 128, I_OUT = 24 * 32, I_GL = 8 * 16;
    constexpr int NIT = 4 * I_GU + 2 * I_D + I_IN + I_OUT + I_GL;
    unsigned char* ws = a.ws;
    for (int it = gw; it < NIT; it += NGW) {
        int r = it;
        if (r < 4 * I_GU) {
            const int mtx = r / I_GU, rr = r % I_GU, j = mtx >> 1, isup = mtx & 1;
            const int kb = rr / 88, nb = rr % 88, ns0 = 32 * nb;
            const float* W = (isup ? a.in[I_WUP] : a.in[I_WGATE]) + (size_t)(L * 2 + j) * DM * DFF;
            bf16_t* WT = (bf16_t*)(ws + (j ? WS_WGU2 : WS_WGU1));
            transpose_item(W, DFF, DM, WT, 64 * kb, ns0, (ns0 >> 7) * 256 + (ns0 & 127) + isup * 128, scr, lane, a.in[I_NORMG] + (size_t)(L * 6 + (j ? 4 : 0)) * DM); continue;
        }
        r -= 4 * I_GU;
        if (r < 2 * I_D) {
            const int j = r / I_D, rr = r % I_D, kb = rr / 32, nb = rr % 32;
            const float* W = a.in[I_WDOWN] + (size_t)(L * 2 + j) * DFF * DM;
            transpose_item(W, DM, DFF, (bf16_t*)(ws + (j ? WS_WD2 : WS_WD1)), 64 * kb, 32 * nb, 32 * nb, scr, lane); continue;
        }
        r -= 2 * I_D;
        if (r < I_IN) {
            const int kb = r / 128, nb = r % 128, dr0 = 32 * nb, seg = dr0 >> 9, o = dr0 & 511;
            const int src = seg == 0 ? 0 : seg == 1 ? 2048 : seg == 2 ? 3592 : seg == 3 ? 512 : seg == 4 ? 1024 : seg == 5 ? 1536 : seg == 6 ? 2560 : 3072;
            transpose_item(a.in[I_WIN] + (size_t)L * DM * DIN, DIN, DM, (bf16_t*)(ws + WS_WIN), 64 * kb, src + o, dr0, scr, lane, a.in[I_NORMG] + (size_t)(L * 6 + 2) * DM); continue;
        }
        r -= I_IN;
        if (r < I_OUT) { const int kb = r / 32, nb = r % 32;
            transpose_item(a.in[I_WOUT] + (size_t)L * DMIX * DM, DM, DMIX, (bf16_t*)(ws + WS_WOUT), 64 * kb, 32 * nb, 32 * nb, scr, lane); continue; }
        r -= I_OUT;
        { const int kb = r / 16, nb = r % 16;
          transpose_item(a.in[I_GLUW] + (size_t)L * 512 * 512, 512, 512, (bf16_t*)(ws + WS_WGLU), 64 * kb, 32 * nb, 32 * nb, scr, lane); }
    }
    for (int idx = blockIdx.x * 512 + tid; idx < 16384; idx += gridDim.x * 512) {
        const int n = idx >> 10, k = idx & 1023;
        ((bf16_t*)(ws + WS_WDT))[idx] = n < 8 ? f2bf(a.in[I_WIN][(size_t)L * DM * DIN + (size_t)k * DIN + 3584 + n] * a.in[I_NORMG][(size_t)(L * 6 + 2) * DM + k]) : (bf16_t)0;
    }
}

template <bool FIRST, bool DT, bool WXN>
__device__ __forceinline__ void rowpass(LAS unsigned char* lds, const float* hin, float* hout, const bf16_t* Y, float scale, const float* gpost, const float* gpre,
                                        bf16_t* XN, const float* winL, float* dtout) {
    const int tid = threadIdx.x, lane = tid & 63, w = tid >> 6;
    LAS f32x4* wd = (LAS f32x4*)lds;
    if (DT) {
        LAS float* wdf = (LAS float*)lds;
        for (int idx = tid; idx < 8192; idx += 512) { const int k = idx >> 3, c = idx & 7, l = (k & 255) >> 2, e = k & 3, j = k >> 8, half = c >> 2;
            wdf[((((j * 4 + e) * 2 + half) * 64 + l) << 2) + (c & 3)] = winL[(size_t)k * DIN + 3584 + c]; }
        __syncthreads();
    }
    f32x4 gp[4], gq[4];
#pragma unroll
    for (int j = 0; j < 4; ++j) { gp[j] = FIRST ? (f32x4){0.f, 0.f, 0.f, 0.f} : *(const f32x4*)(gpost + 4 * lane + 256 * j); gq[j] = WXN ? *(const f32x4*)(gpre + 4 * lane + 256 * j) : (f32x4){0.f, 0.f, 0.f, 0.f}; }
    for (int row = blockIdx.x * 8 + w; row < NTOK; row += gridDim.x * 8) {
        f32x4 hv[4];
#pragma unroll
        for (int j = 0; j < 4; ++j) hv[j] = *(const f32x4*)(hin + (size_t)row * DM + 4 * lane + 256 * j);
        if (!FIRST) {
            f32x4 yv[4]; float ss = 0.f;
#pragma unroll
            for (int j = 0; j < 4; ++j) { yv[j] = unpack4(*(const u32x2*)(Y + (size_t)row * DM + 4 * lane + 256 * j)); ss += (yv[j][0] * yv[j][0] + yv[j][1] * yv[j][1]) + (yv[j][2] * yv[j][2] + yv[j][3] * yv[j][3]); }
            const float rs = scale * __frsqrt_rn(wave_sum(ss) * (1.f / DM) + EPS);
#pragma unroll
            for (int j = 0; j < 4; ++j) hv[j] = hv[j] + (yv[j] * rs) * gp[j];
        }
#pragma unroll
        for (int j = 0; j < 4; ++j) *(f32x4*)(hout + (size_t)row * DM + 4 * lane + 256 * j) = hv[j];
        if (WXN) {
            float s2 = 0.f;
#pragma unroll
            for (int j = 0; j < 4; ++j) s2 += (hv[j][0] * hv[j][0] + hv[j][1] * hv[j][1]) + (hv[j][2] * hv[j][2] + hv[j][3] * hv[j][3]);
            const float r2 = __frsqrt_rn(wave_sum(s2) * (1.f / DM) + EPS);
            f32x4 xn[4];
#pragma unroll
            for (int j = 0; j < 4; ++j) { xn[j] = (hv[j] * r2) * gq[j]; *(u32x2*)(XN + (size_t)row * DM + 4 * lane + 256 * j) = pack4(xn[j]); }
            if (DT) {
                f32x4 d0 = {0.f, 0.f, 0.f, 0.f}, d1 = {0.f, 0.f, 0.f, 0.f};
#pragma unroll
                for (int j = 0; j < 4; ++j)
#pragma unroll
                    for (int e = 0; e < 4; ++e) { const float xv = xn[j][e]; d0 = d0 + wd[((j * 4 + e) * 2 + 0) * 64 + lane] * xv; d1 = d1 + wd[((j * 4 + e) * 2 + 1) * 64 + lane] * xv; }
                float o = 0.f;
#pragma unroll
                for (int c = 0; c < 4; ++c) { const float s0 = wave_sum(d0[c]), s1 = wave_sum(d1[c]); if (lane == c) o = s0; if (lane == 4 + c) o = s1; }
                if (lane < 8) dtout[(size_t)row * 8 + lane] = o;
            }
        }
    }
}


__device__ __forceinline__ void dt_pass(const bf16_t* XN, const bf16_t* WDT, const float* RS, float* dtout) {
    const int lane = threadIdx.x & 63, w = threadIdx.x >> 6, r = lane & 15, q = lane >> 4;
    for (int wt = w * gridDim.x + blockIdx.x; wt < NTOK / 16; wt += gridDim.x * 8) {
        const bf16_t* xp = XN + (size_t)(16 * wt + r) * DM + 8 * q; const bf16_t* wp = WDT + (size_t)r * DM + 8 * q;
        f32x4 acc = {0.f, 0.f, 0.f, 0.f};
#pragma unroll
        for (int kb = 0; kb < 4; ++kb) {
            bf16x8 xf[8], wf[8];
#pragma unroll
            for (int ks = 0; ks < 8; ++ks) { xf[ks] = *(const bf16x8*)(xp + 32 * (kb * 8 + ks)); wf[ks] = *(const bf16x8*)(wp + 32 * (kb * 8 + ks)); }
#pragma unroll
            for (int ks = 0; ks < 8; ++ks) acc = mma(wf[ks], xf[ks], acc);
        }
        if (q < 2) *(f32x4*)(dtout + (size_t)(16 * wt + r) * 8 + 4 * q) = acc * RS[16 * wt + r];
    }
}


__device__ __forceinline__ void r0_pass(const float* x, bf16_t* HBo, float* RS) {
    const int lane = threadIdx.x & 63, w = threadIdx.x >> 6;
    for (int row = (blockIdx.x * 8 + w) * 2; row < NTOK; row += gridDim.x * 16) {
        f32x4 hv[2][4];
#pragma unroll
        for (int rr = 0; rr < 2; ++rr)
#pragma unroll
            for (int j = 0; j < 4; ++j) hv[rr][j] = *(const f32x4*)(x + (size_t)(row + rr) * DM + 4 * lane + 256 * j);
#pragma unroll
        for (int rr = 0; rr < 2; ++rr) {
            float s2 = 0.f;
#pragma unroll
            for (int j = 0; j < 4; ++j) { s2 += (hv[rr][j][0] * hv[rr][j][0] + hv[rr][j][1] * hv[rr][j][1]) + (hv[rr][j][2] * hv[rr][j][2] + hv[rr][j][3] * hv[rr][j][3]);
                *(u32x2*)(HBo + (size_t)(row + rr) * DM + 4 * lane + 256 * j) = pack4(hv[rr][j]); }
            const float r2 = __frsqrt_rn(wave_sum(s2) * (1.f / DM) + EPS);
            if (lane == 0) RS[row + rr] = r2;
        }
    }
}

__device__ __forceinline__ void sincos_d(double x, double& s, double& c) {
    const double TWO_PI = 6.283185307179586476925286766559;
    x = x - TWO_PI * rint(x / TWO_PI);
    const double y = x * 0.125, y2 = y * y;
    double sy = y * (1.0 + y2 * (-1.0 / 6 + y2 * (1.0 / 120 + y2 * (-1.0 / 5040 + y2 * (1.0 / 362880 + y2 * (-1.0 / 39916800 + y2 * (1.0 / 6227020800.0)))))));
    double cy = 1.0 + y2 * (-0.5 + y2 * (1.0 / 24 + y2 * (-1.0 / 720 + y2 * (1.0 / 40320 + y2 * (-1.0 / 3628800 + y2 * (1.0 / 479001600.0))))));
#pragma unroll
    for (int i = 0; i < 3; ++i) { const double s2 = 2.0 * sy * cy, c2 = cy * cy - sy * sy; sy = s2; cy = c2; }
    s = sy; c = cy;
}
__device__ __forceinline__ void setup_params(const Args& a) {
    const int gt = blockIdx.x * 512 + threadIdx.x;
    unsigned char* ws = a.ws;
    if (gt < 512) { float* lb = (float*)(ws + WS_LB); const float a0 = a.in[I_LBLOG][gt], a1 = a.in[I_LBLOG][512 + gt]; lb[gt] = 0.f; lb[512 + gt] = 1.f / (1.f + expf(a0 - a1)); }
    if (gt < 4096) {
        const int L = gt >> 11, g = (gt >> 6) & 31, p = gt & 63, gi = (L * 32 + g) * 64 + p;
        unsigned char* base = ws + WS_S5P + (size_t)L * S5P_STRIDE;
        const double delta = exp((double)a.in[I_S5LDT][L * 32 + g]);
        const double ar = a.in[I_S5ARE][gi], ai = a.in[I_S5AIM][gi];
        const double mag = exp(ar * delta); double sn, cs; sincos_d(ai * delta, sn, cs);
        const double abr = mag * cs, abi = mag * sn, den = ar * ar + ai * ai, nr = abr - 1.0, ni = abi;
        const double fr = (nr * ar + ni * ai) / den, fi = (ni * ar - nr * ai) / den;
        double pr = abr, pi = abi;
#pragma unroll
        for (int i = 0; i < 6; ++i) { const double tr = pr * pr - pi * pi, ti = 2.0 * pr * pi; pr = tr; pi = ti; }
        ((f32x2*)(base + S5P_ABAR))[g * 64 + p] = (f32x2){(float)abr, (float)abi};
        ((f32x2*)(base + S5P_A64))[g * 64 + p] = (f32x2){(float)pr, (float)pi};
        bf16_t* bbp = (bf16_t*)(base + S5P_BBP); bf16_t* cm = (bf16_t*)(base + S5P_CM);
        for (int cc = 0; cc < 16; ++cc) {
            const double br = a.in[I_S5BRE][(size_t)gi * 16 + cc], bi = a.in[I_S5BIM][(size_t)gi * 16 + cc];
            bbp[(g * 128 + p) * 32 + cc] = f2bf((float)(fr * br - fi * bi)); bbp[(g * 128 + p) * 32 + 16 + cc] = 0;
            bbp[(g * 128 + 64 + p) * 32 + cc] = f2bf((float)(fr * bi + fi * br)); bbp[(g * 128 + 64 + p) * 32 + 16 + cc] = 0;
            const size_t ci = ((size_t)(L * 32 + g) * 16 + cc) * 64 + p;
            cm[(g * 16 + cc) * 128 + 2 * p] = f2bf(a.in[I_S5CRE][ci]); cm[(g * 16 + cc) * 128 + 2 * p + 1] = f2bf(-a.in[I_S5CIM][ci]);
        }
    }
}

#define RLX_AGENT __ATOMIC_RELAXED, __HIP_MEMORY_SCOPE_AGENT
#define XB_TMO      128
#define XB_XCNT(j)  (256  + 64 * (j))
#define XB_XSUB(j)  (1280 + 64 * (j))
#define XB_XGEN(j)  (2304 + 64 * (j))
#define XB_TOP      3328
#define XB_TOPGEN   3392
#define XCD_BAR_WORDS 3456
#define XB_SPIN_CAP (1u << 18)

__device__ __forceinline__ unsigned xb_ld(unsigned* p)              { return __hip_atomic_load(p, __ATOMIC_RELAXED, __HIP_MEMORY_SCOPE_AGENT); }
__device__ __forceinline__ unsigned xb_add(unsigned* p, unsigned v) { return __hip_atomic_fetch_add(p, v, __ATOMIC_RELAXED, __HIP_MEMORY_SCOPE_AGENT); }
__device__ __forceinline__ unsigned xb_xcc_id() { return (unsigned)__builtin_amdgcn_s_getreg((3 << 11) | 20) & 0xFu; }
#define XB_SPIN(cond, bar) do { unsigned _sp = 0; while (cond) { __builtin_amdgcn_s_sleep(1); \
    if ((++_sp & 255u) == 0u) { if (xb_ld(&(bar)[XB_TMO])) break; if (_sp > XB_SPIN_CAP) { atomicAdd(&(bar)[XB_TMO], 1u); break; } } } } while (0)

struct XcdBarrier {
    unsigned* bar; unsigned x;
    volatile LAS unsigned* st;
};

__device__ __forceinline__ XcdBarrier xcd_barrier_post(unsigned* bar, volatile LAS unsigned* st) {
    XcdBarrier b; b.bar = bar; b.x = xb_xcc_id(); b.st = st;
    if (threadIdx.x == 0) (void)xb_add(&bar[XB_XCNT(b.x)], 1u);
    return b;
}
__device__ __forceinline__ void xcd_barrier_complete(unsigned* bar, unsigned x, unsigned& nloc, unsigned& nx) {
    const unsigned G = gridDim.x * gridDim.y * gridDim.z;
    unsigned sum, cnt, mine, sp = 0u;
    for (;;) {
        sum = 0u; cnt = 0u; mine = 0u;
#pragma unroll
        for (unsigned j = 0; j < 16; ++j) { const unsigned c = xb_ld(&bar[XB_XCNT(j)]); sum += c; cnt += (c > 0u) ? 1u : 0u; mine = (j == x) ? c : mine; }
        if (sum == G) break;
        __builtin_amdgcn_s_sleep(1);
        if ((++sp & 255u) == 0u) { if (xb_ld(&bar[XB_TMO])) break; if (sp > XB_SPIN_CAP) { atomicAdd(&bar[XB_TMO], 1u); break; } }
    }
    nloc = mine > 0u ? mine : 1u; nx = cnt > 0u ? cnt : 1u;
}

__device__ __forceinline__ void xcd_barrier(const XcdBarrier& b) {
    asm volatile("s_waitcnt vmcnt(0)" ::: "memory");
    __syncthreads();
    if (threadIdx.x == 0) {
        unsigned* bar = b.bar;
        __builtin_amdgcn_s_waitcnt(0);
        unsigned nloc = b.st[0], nx = b.st[1];
        if (nloc == 0u) { xcd_barrier_complete(bar, b.x, nloc, nx); b.st[0] = nloc; b.st[1] = nx; }
        const unsigned old = xb_add(&bar[XB_XSUB(b.x)], 1u);
        const unsigned gen = old / nloc;
        if (old + 1u == (gen + 1u) * nloc) {
            __builtin_amdgcn_fence(__ATOMIC_RELEASE, "agent");
            asm volatile("s_waitcnt vmcnt(0)" ::: "memory");
            const unsigned og = xb_add(&bar[XB_TOP], 1u);
            const unsigned tg = og / nx;
            if (og + 1u == (tg + 1u) * nx) xb_add(&bar[XB_TOPGEN], 1u);
            else XB_SPIN(xb_ld(&bar[XB_TOPGEN]) == tg, bar);
            __builtin_amdgcn_fence(__ATOMIC_ACQUIRE, "agent");
            xb_add(&bar[XB_XGEN(b.x)], 1u);
            asm volatile("s_waitcnt vmcnt(0)" ::: "memory");
        } else {
            XB_SPIN(xb_ld(&bar[XB_XGEN(b.x)]) == gen, bar);
            __builtin_amdgcn_fence(__ATOMIC_ACQUIRE, "agent");
            asm volatile("s_waitcnt vmcnt(0)" ::: "memory");
        }
    }
    __syncthreads();
}


#ifndef DBG_HG
#define DBG_HG 0
#endif


__device__ __forceinline__ float rcpf_(float x) { return __builtin_amdgcn_rcpf(x); }
__device__ __forceinline__ float lo16f(unsigned u) { return __builtin_bit_cast(float, u << 16); }
__device__ __forceinline__ float hi16f(unsigned u) { return __builtin_bit_cast(float, u & 0xffff0000u); }

struct HgIn { unsigned fr[8], vr[8], qr[8]; };
struct HgLate { u32x4 sreg[4]; u32x4 greg[2]; };
template <int MODE>
__device__ __forceinline__ void hg_late(const Args& a, int it, HgLate& T) {
    const int tid = threadIdx.x, lane = tid & 63, w = tid >> 6, r = lane & 15, q = lane >> 4;
    const int b = it >> 9, h = (it >> 7) & 3, c = it & 127;
    if (MODE == 3) {
        const unsigned char* Pg = a.ws + WS_PROJ + (size_t)(b * 128 + c) * PT_CS + (size_t)(CT_G + h) * 16384;
        const bf16_t* Sg = (const bf16_t*)(a.ws + WS_HGS) + (size_t)it * 16384;
#pragma unroll
        for (int j = 0; j < 4; ++j) T.sreg[j] = __builtin_nontemporal_load((const u32x4*)(Sg + (size_t)(tid + 512 * j) * 8));
#pragma unroll
        for (int pi = 0; pi < 2; ++pi) T.greg[pi] = *(const u32x4*)(Pg + (16 * (w >> 1) + r) * 256 + (32 * (2 * (w & 1) + pi) + 8 * q) * 2);
    }
}
template <int MODE>
__device__ __forceinline__ void hg_load(const Args& a, int it, HgIn& R) {
    const int tid = threadIdx.x, lane = tid & 63, w = tid >> 6;
    const int b = it >> 9, h = (it >> 7) & 3, c = it & 127;
    const unsigned char* P = a.ws + WS_PROJ + (size_t)(b * 128 + c) * PT_CS + (size_t)h * 16384 + (8 * w) * 256 + 4 * lane;
#pragma unroll
    for (int j = 0; j < 8; ++j) { const unsigned char* pr = P + j * 256; R.fr[j] = *(const unsigned*)(pr + CT_F * 16384); R.vr[j] = *(const unsigned*)(pr + CT_I * 16384); if (MODE == 3) R.qr[j] = *(const unsigned*)(pr + CT_Q * 16384); }
}
template <int MODE>
__device__ __forceinline__ void hg_compute(LAS unsigned char* lds, const Args& a, int L, int it, const HgIn& R, const HgLate& T) {
    const int tid = threadIdx.x, lane = tid & 63, w = tid >> 6, r = lane & 15, q = lane >> 4;
    const int b = it >> 9, h = (it >> 7) & 3, c = it & 127;
    unsigned char* Pq = a.ws + WS_PROJ + (size_t)(b * 128 + c) * PT_CS + (size_t)(CT_Q + h) * 16384;
    LAS bf16_t* Qt = (LAS bf16_t*)(lds + 0);
    LAS bf16_t* Kt = (LAS bf16_t*)(lds + 17408);
    LAS bf16_t* Qi = (LAS bf16_t*)(lds + 34816);
    LAS bf16_t* VT = (LAS bf16_t*)(lds + 52224);
    LAS bf16_t* KsT = (LAS bf16_t*)(lds + 0);
    LAS bf16_t* Sc = (LAS bf16_t*)(lds + 70656);
    LAS float* tot = (LAS float*)(lds + 79872);
    LAS float* red = (LAS float*)(lds + 83968);
    LAS bf16_t* Ss = (LAS bf16_t*)(lds + 84480);
    const u32x4 (&sreg)[4] = T.sreg; const u32x4 (&greg)[2] = T.greg;
    const f32x2 lb2 = *(const f32x2*)((const float*)(a.ws + WS_LB) + L * 512 + h * 128 + 2 * lane);
    float cs[2][8], km[2][8], run[2] = {0.f, 0.f};
#pragma unroll
    for (int j = 0; j < 8; ++j)
#pragma unroll
        for (int c2 = 0; c2 < 2; ++c2) {
            const float z = c2 ? hi16f(R.fr[j]) : lo16f(R.fr[j]), lbk = c2 ? lb2.y : lb2.x;
            const float e = __expf(-z), sg = rcpf_(1.f + e), f = lbk + (1.f - lbk) * sg;
            km[c2][j] = (1.f - lbk) * e * sg;
            run[c2] += __log2f(f); cs[c2][j] = run[c2];
        }
    *(LAS f32x2*)(tot + w * 128 + 2 * lane) = (f32x2){run[0], run[1]};
    {
        u32x4 v0, v1;
#pragma unroll
        for (int j = 0; j < 4; ++j) { v0[j] = (R.vr[2 * j] & 0xffffu) | (R.vr[2 * j + 1] << 16); v1[j] = (R.vr[2 * j] >> 16) | (R.vr[2 * j + 1] & 0xffff0000u); }
        *(LAS u32x4*)(VT + (2 * lane) * 72 + 8 * w) = v0; *(LAS u32x4*)(VT + (2 * lane + 1) * 72 + 8 * w) = v1;
    }
    if (MODE == 3) {
#pragma unroll
        for (int j = 0; j < 4; ++j) { const int idx = tid + 512 * j; *(LAS u32x4*)(Ss + (idx >> 4) * 136 + (idx & 15) * 8) = sreg[j]; }
    }
    __syncthreads();
    float off[2] = {0.f, 0.f}, bmid[2] = {0.f, 0.f}, blast[2] = {0.f, 0.f};
#pragma unroll
    for (int s = 0; s < 8; ++s) { const f32x2 tv = *(const LAS f32x2*)(tot + s * 128 + 2 * lane);
        if (s < w) { off[0] += tv.x; off[1] += tv.y; } if (s < 4) { bmid[0] += tv.x; bmid[1] += tv.y; } blast[0] += tv.x; blast[1] += tv.y; }
    if (MODE == 1) {
        u32x4 k0, k1; float kv[2][8];
#pragma unroll
        for (int j = 0; j < 8; ++j)
#pragma unroll
            for (int c2 = 0; c2 < 2; ++c2) kv[c2][j] = km[c2][j] * __builtin_amdgcn_exp2f(blast[c2] - (cs[c2][j] + off[c2]));
#pragma unroll
        for (int j = 0; j < 4; ++j) { k0[j] = cvt_pk_bf16(kv[0][2 * j], kv[0][2 * j + 1]); k1[j] = cvt_pk_bf16(kv[1][2 * j], kv[1][2 * j + 1]); }
        *(LAS u32x4*)(KsT + (2 * lane) * 72 + 8 * w) = k0; *(LAS u32x4*)(KsT + (2 * lane + 1) * 72 + 8 * w) = k1;
        if (w == 0) *(f32x2*)((float*)(a.ws + WS_HGDEC) + (size_t)it * 128 + 2 * lane) = (f32x2){__builtin_amdgcn_exp2f(blast[0]), __builtin_amdgcn_exp2f(blast[1])};
        __syncthreads();
        f32x4 acc[8];
#pragma unroll
        for (int kt = 0; kt < 8; ++kt) acc[kt] = (f32x4){0.f, 0.f, 0.f, 0.f};
#pragma unroll
        for (int ks = 0; ks < 2; ++ks) {
            const bf16x8 pf = ldsfrag(VT, 16 * w + r, 72, 32 * ks + 8 * q);
#pragma unroll
            for (int kt = 0; kt < 8; ++kt) acc[kt] = mma(ldsfrag(KsT, 32 * (kt >> 1) + pg8::perm32(16 * (kt & 1) + r), 72, 32 * ks + 8 * q), pf, acc[kt]);
        }
        bf16_t* S = (bf16_t*)(a.ws + WS_HGS) + (size_t)it * 16384 + (size_t)(16 * w + r) * 128 + 8 * q;
#pragma unroll
        for (int kt = 0; kt < 8; kt += 2) { const u32x2 lo = pack4(acc[kt]), hi = pack4(acc[kt + 1]); __builtin_nontemporal_store((u32x4){lo.x, lo.y, hi.x, hi.y}, (u32x4*)(S + 16 * kt)); }
    } else {
#pragma unroll
        for (int j = 0; j < 8; ++j) {
            const int t = 8 * w + j; float qt2[2], qi2[2], kt2[2];
#pragma unroll
            for (int c2 = 0; c2 < 2; ++c2) {
                const float bt = cs[c2][j] + off[c2];
                const float qraw = c2 ? hi16f(R.qr[j]) : lo16f(R.qr[j]);
                const float qv = qraw * rcpf_(1.f + __expf(-qraw));
                qt2[c2] = qv * __builtin_amdgcn_exp2f(bt - bmid[c2]); qi2[c2] = qv * __builtin_amdgcn_exp2f(bt); kt2[c2] = km[c2][j] * __builtin_amdgcn_exp2f(bmid[c2] - bt);
            }
            *(LAS unsigned*)(Qt + t * 136 + 2 * lane) = cvt_pk_bf16(qt2[0], qt2[1]);
            *(LAS unsigned*)(Qi + t * 136 + 2 * lane) = cvt_pk_bf16(qi2[0], qi2[1]);
            *(LAS unsigned*)(Kt + t * 136 + 2 * lane) = cvt_pk_bf16(kt2[0], kt2[1]);
        }
        __syncthreads();
        const int tt = w >> 1;
#pragma unroll
        for (int i = 0; i < 2; ++i) {
            const int ts = 2 * (w & 1) + i; f32x4 acc = {0.f, 0.f, 0.f, 0.f};
            if (ts <= tt) {
#pragma unroll
                for (int ks = 0; ks < 4; ++ks) acc = mma(ldsfrag(Kt, 16 * ts + r, 136, 32 * ks + 8 * q), ldsfrag(Qt, 16 * tt + r, 136, 32 * ks + 8 * q), acc);
            }
            const int t = 16 * tt + r, s0 = 16 * ts + 4 * q;
#pragma unroll
            for (int jj = 0; jj < 4; ++jj) if (s0 + jj > t) acc[jj] = 0.f;
            *(LAS u32x2*)(Sc + t * 72 + s0) = pack4(acc);
        }
        __syncthreads();
        f32x4 o[4]; float ss = 0.f;
#pragma unroll
        for (int i = 0; i < 4; ++i) {
            const int vt = 4 * (w & 1) + i; f32x4 acc = {0.f, 0.f, 0.f, 0.f};
            const int vrow = 32 * (vt >> 1) + pg8::perm32(16 * (vt & 1) + r);
#pragma unroll
            for (int ks = 0; ks < 4; ++ks) acc = mma(ldsfrag(Ss, vrow, 136, 32 * ks + 8 * q), ldsfrag(Qi, 16 * tt + r, 136, 32 * ks + 8 * q), acc);
#pragma unroll
            for (int ks = 0; ks < 2; ++ks) acc = mma(ldsfrag(VT, vrow, 72, 32 * ks + 8 * q), ldsfrag(Sc, 16 * tt + r, 72, 32 * ks + 8 * q), acc);
            o[i] = acc; ss += (acc[0] * acc[0] + acc[1] * acc[1]) + (acc[2] * acc[2] + acc[3] * acc[3]);
        }
        ss += __shfl_xor(ss, 16); ss += __shfl_xor(ss, 32);
        if (q == 0) red[w * 16 + r] = ss;
        __syncthreads();
        const float rstd = __frsqrt_rn((red[w * 16 + r] + red[(w ^ 1) * 16 + r]) * (1.f / 128.f) + EPS);
        const int t = 16 * tt + r;
#pragma unroll
        for (int pi = 0; pi < 2; ++pi) {
            const int v0 = 32 * (2 * (w & 1) + pi) + 8 * q; u32x2 pk[2];
#pragma unroll
            for (int n = 0; n < 2; ++n) {
                const f32x4 gr = unpack4((u32x2){n ? greg[pi].z : greg[pi].x, n ? greg[pi].w : greg[pi].y});
                const f32x4 gn = *(const f32x4*)(a.in[I_GNORM] + L * 128 + v0 + 4 * n); f32x4 ov;
#pragma unroll
                for (int jj = 0; jj < 4; ++jj) ov[jj] = o[2 * pi + n][jj] * rstd * gn[jj] * gr[jj] * rcpf_(1.f + __expf(-gr[jj]));
                pk[n] = pack4(ov);
            }
            *(u32x4*)(Pq + t * 256 + v0 * 2) = (u32x4){pk[0].x, pk[0].y, pk[1].x, pk[1].y};
        }
    }
}
template <int MODE>
__device__ __forceinline__ void hg_phase(LAS unsigned char* lds, const Args& a, int L) {
    HgIn cur, nxt;
    int it = blockIdx.x;
    if (it < 1024) hg_load<MODE>(a, it, cur);
    bool first = true;
    for (; it < 1024; it += gridDim.x) {
        const int itn = it + gridDim.x;
        if (itn < 1024) hg_load<MODE>(a, itn, nxt);
        if (MODE == 1) __syncthreads();
        first = false;
        HgLate late; hg_late<MODE>(a, it, late);
        hg_compute<MODE>(lds, a, L, it, cur, late);
        cur = nxt;
    }
}

struct SsdIn { unsigned xr[35]; float dtr; };
struct SsdLate { f32x2 cw[4], cb; u32x4 zreg[4]; u32x4 hreg[4][2]; };
__device__ __forceinline__ int ssd_xch(int ic, int g) { return ic < 256 ? g * 256 + ic : ic < 384 ? 512 + g * 128 + (ic - 256) : 768 + g * 128 + (ic - 384); }
__device__ __forceinline__ int ssd_toff(int ic, int g) { const int x = ssd_xch(ic, g); return (CT_X + (x >> 7)) * 16384 + (x & 127) * 2; }
template <int MODE>
__device__ __forceinline__ void ssd_load(const Args& a, int it, SsdIn& R) {
    const int tid = threadIdx.x, lane = tid & 63, w = tid >> 6;
    const int b = it >> 8, c = (it >> 1) & 127, g = it & 1;
    const size_t row0 = (size_t)b * SEQ + c * 64;
    const int ic = 2 * (tid & 255), th = tid >> 8;
    if (MODE == 3 || ic < 384) {
        const unsigned char* px = a.ws + WS_PROJ + (size_t)(b * 128 + c) * PT_CS + ssd_toff(ic, g) + (32 * th) * 256;
        const bool hist = !(c == 0 && th == 0);
        const unsigned char* ph = th ? px - 3 * 256 : px - PT_CS + 61 * 256;
#pragma unroll
        for (int i = 0; i < 3; ++i) R.xr[i] = hist ? *(const unsigned*)(ph + i * 256) : 0u;
#pragma unroll
        for (int i = 3; i < 35; ++i) R.xr[i] = *(const unsigned*)(px + (i - 3) * 256);
    }
    if (w < 4) R.dtr = ((const float*)(a.ws + WS_DT))[(row0 + lane) * 8 + g * 4 + w];
}
template <int MODE>
__device__ __forceinline__ void ssd_late(const Args& a, int L, int it, SsdLate& T) {
    const int tid = threadIdx.x, lane = tid & 63, w = tid >> 6, r = lane & 15, q = lane >> 4;
    const int b = it >> 8, c = (it >> 1) & 127, g = it & 1;
    const int ic = 2 * (tid & 255), xch = ssd_xch(ic, g);
#pragma unroll
    for (int j = 0; j < 4; ++j) T.cw[j] = *(const f32x2*)(a.in[I_CONVW] + L * 4096 + j * 1024 + xch);
    T.cb = *(const f32x2*)(a.in[I_CONVB] + L * 1024 + xch);
    if (MODE == 3) {
        const unsigned char* Pz = a.ws + WS_PROJ + (size_t)(b * 128 + c) * PT_CS + (size_t)(CT_Z + 2 * g) * 16384;
        const bf16_t* Hs = (const bf16_t*)(a.ws + WS_SSDS) + ((size_t)(b * 128 + c) * 8 + g * 4) * 8192;
#pragma unroll
        for (int hh = 0; hh < 4; ++hh) {
            T.zreg[hh] = *(const u32x4*)(Pz + (hh >> 1) * 16384 + (16 * (w >> 1) + r) * 256 + ((hh & 1) * 64 + 32 * (w & 1) + 8 * q) * 2);
#pragma unroll
            for (int i = 0; i < 2; ++i) T.hreg[hh][i] = __builtin_nontemporal_load((const u32x4*)(Hs + (size_t)hh * 8192 + (size_t)(tid + 512 * i) * 8));
        }
    }
}
template <int MODE>
__device__ __forceinline__ void ssd_compute(LAS unsigned char* lds, const Args& a, int L, int it, const SsdIn& R, const SsdLate& T) {
    const int tid = threadIdx.x, lane = tid & 63, w = tid >> 6, r = lane & 15, q = lane >> 4;
    const int b = it >> 8, c = (it >> 1) & 127, g = it & 1;
    const size_t row0 = (size_t)b * SEQ + c * 64;
    unsigned char* Pz = a.ws + WS_PROJ + (size_t)(b * 128 + c) * PT_CS + (size_t)(CT_Z + 2 * g) * 16384;
    LAS float* DTs = (LAS float*)(lds + 0);
    LAS float* ACS = (LAS float*)(lds + 1024);
    LAS float* red = (LAS float*)(lds + 2048);
    LAS bf16_t* Cm = (LAS bf16_t*)(lds + 4096);
    LAS bf16_t* Bm = (LAS bf16_t*)(lds + 21504);
    LAS bf16_t* XT = (LAS bf16_t*)(lds + 38912);
    LAS bf16_t* Mh = (LAS bf16_t*)(lds + 75776);
    LAS bf16_t* Hb1 = (LAS bf16_t*)(lds + 112640);
    LAS bf16_t* XdT = (LAS bf16_t*)(lds + 4096);
    LAS bf16_t* BT = (LAS bf16_t*)(lds + 40960);
    if (w < 4) {
        const int hd = L * 8 + g * 4 + w;
        const float dtr = R.dtr + a.in[I_DTB][hd];
        const float dtv = dtr > 20.f ? dtr : log1pf(__expf(dtr));
        float v = -dtv * __expf(a.in[I_ALOG][hd]);
#pragma unroll
        for (int o = 1; o < 64; o <<= 1) { const float n = __shfl_up(v, o); if (lane >= o) v += n; }
        DTs[w * 64 + lane] = dtv; ACS[w * 64 + lane] = v;
    }
    if (MODE == 1) __syncthreads();
    {
        const int ic = 2 * (tid & 255), th = tid >> 8;
        if (MODE == 3 || ic < 384) {
            const int hh = (ic >> 6) & 3;
            const float alast = MODE == 1 ? ACS[hh * 64 + 63] : 0.f;
#pragma unroll
            for (int j8 = 0; j8 < 4; ++j8) {
                float val[2][8];
#pragma unroll
                for (int jj = 0; jj < 8; ++jj) {
                    const int j = j8 * 8 + jj;
#pragma unroll
                    for (int c2 = 0; c2 < 2; ++c2) {
                        const float x3 = c2 ? hi16f(R.xr[j]) : lo16f(R.xr[j]), x2 = c2 ? hi16f(R.xr[j + 1]) : lo16f(R.xr[j + 1]);
                        const float x1 = c2 ? hi16f(R.xr[j + 2]) : lo16f(R.xr[j + 2]), x0 = c2 ? hi16f(R.xr[j + 3]) : lo16f(R.xr[j + 3]);
                        const float v = (c2 ? T.cw[0].y : T.cw[0].x) * x3 + (c2 ? T.cw[1].y : T.cw[1].x) * x2 + (c2 ? T.cw[2].y : T.cw[2].x) * x1 + (c2 ? T.cw[3].y : T.cw[3].x) * x0 + (c2 ? T.cb.y : T.cb.x);
                        val[c2][jj] = v * rcpf_(1.f + __expf(-v));
                    }
                }
                const int tb = 32 * th + 8 * j8;
                if (ic < 256) {
                    if (MODE == 1) {
#pragma unroll
                        for (int jj = 0; jj < 8; ++jj) { const float s = DTs[hh * 64 + tb + jj] * __expf(alast - ACS[hh * 64 + tb + jj]); val[0][jj] *= s; val[1][jj] *= s; }
                    }
                    LAS bf16_t* dst = (MODE == 1 ? XdT : XT) + ic * 72 + tb;
#pragma unroll
                    for (int c2 = 0; c2 < 2; ++c2)
                        *(LAS u32x4*)(dst + c2 * 72) = (u32x4){cvt_pk_bf16(val[c2][0], val[c2][1]), cvt_pk_bf16(val[c2][2], val[c2][3]), cvt_pk_bf16(val[c2][4], val[c2][5]), cvt_pk_bf16(val[c2][6], val[c2][7])};
                } else if (ic < 384) {
                    const int n = ic - 256;
                    if (MODE == 1) {
#pragma unroll
                        for (int c2 = 0; c2 < 2; ++c2)
                            *(LAS u32x4*)(BT + (n + c2) * 72 + tb) = (u32x4){cvt_pk_bf16(val[c2][0], val[c2][1]), cvt_pk_bf16(val[c2][2], val[c2][3]), cvt_pk_bf16(val[c2][4], val[c2][5]), cvt_pk_bf16(val[c2][6], val[c2][7])};
                    } else {
#pragma unroll
                        for (int jj = 0; jj < 8; ++jj) *(LAS unsigned*)(Bm + (tb + jj) * 136 + n) = cvt_pk_bf16(val[0][jj], val[1][jj]);
                    }
                } else {
                    const int n = ic - 384;
#pragma unroll
                    for (int jj = 0; jj < 8; ++jj) *(LAS unsigned*)(Cm + (tb + jj) * 136 + n) = cvt_pk_bf16(val[0][jj], val[1][jj]);
                }
            }
        }
    }
    __syncthreads();
    const size_t sbase = ((size_t)(b * 128 + c) * 8 + g * 4) * 8192;
    if (MODE == 1) {
        const int hh = w >> 1;
        f32x4 acc[2][8];
#pragma unroll
        for (int i = 0; i < 2; ++i)
#pragma unroll
            for (int nt = 0; nt < 8; ++nt) acc[i][nt] = (f32x4){0.f, 0.f, 0.f, 0.f};
#pragma unroll
        for (int ks = 0; ks < 2; ++ks) {
            bf16x8 pf[2];
#pragma unroll
            for (int i = 0; i < 2; ++i) pf[i] = ldsfrag(XdT, hh * 64 + 16 * (2 * (w & 1) + i) + r, 72, 32 * ks + 8 * q);
#pragma unroll
            for (int nt = 0; nt < 8; ++nt) { const bf16x8 bf = ldsfrag(BT, 32 * (nt >> 1) + pg8::perm32(16 * (nt & 1) + r), 72, 32 * ks + 8 * q);
#pragma unroll
                for (int i = 0; i < 2; ++i) acc[i][nt] = mma(bf, pf[i], acc[i][nt]); }
        }
        bf16_t* S = (bf16_t*)(a.ws + WS_SSDS) + sbase + (size_t)hh * 8192;
#pragma unroll
        for (int i = 0; i < 2; ++i)
#pragma unroll
            for (int nt = 0; nt < 8; nt += 2) { const u32x2 lo = pack4(acc[i][nt]), hi = pack4(acc[i][nt + 1]);
                __builtin_nontemporal_store((u32x4){lo.x, lo.y, hi.x, hi.y}, (u32x4*)(S + (size_t)(16 * (2 * (w & 1) + i) + r) * 128 + 16 * nt + 8 * q)); }
        if (tid < 4) ((float*)(a.ws + WS_SSDDEC))[(size_t)(b * 128 + c) * 8 + g * 4 + tid] = __expf(ACS[tid * 64 + 63]);
    } else {
        const int tl = w >> 1, l = 16 * tl + r;
#pragma unroll
        for (int i = 0; i < 2; ++i) {
            const int ts = 2 * (w & 1) + i; f32x4 acc = {0.f, 0.f, 0.f, 0.f};
            if (ts <= tl) {
#pragma unroll
                for (int ks = 0; ks < 4; ++ks) acc = mma(ldsfrag(Bm, 16 * ts + r, 136, 32 * ks + 8 * q), ldsfrag(Cm, 16 * tl + r, 136, 32 * ks + 8 * q), acc);
            }
            const int s0 = 16 * ts + 4 * q;
#pragma unroll
            for (int hh = 0; hh < 4; ++hh) {
                const float al = ACS[hh * 64 + l]; f32x4 mv;
#pragma unroll
                for (int jj = 0; jj < 4; ++jj) { const int s = s0 + jj; mv[jj] = (s <= l) ? acc[jj] * __expf(al - ACS[hh * 64 + s]) * DTs[hh * 64 + s] : 0.f; }
                *(LAS u32x2*)(Mh + (hh * 64 + l) * 72 + s0) = pack4(mv);
            }
        }
#pragma unroll
        for (int i = 0; i < 2; ++i) { const int idx = tid + 512 * i; *(LAS u32x4*)(Hb1 + (idx >> 4) * 136 + (idx & 15) * 8) = T.hreg[0][i]; }
        __syncthreads();
        f32x4 yr[4][2]; float ss = 0.f;
#pragma unroll
        for (int hh = 0; hh < 4; ++hh) {
            LAS bf16_t* Hc = (hh & 1) ? Bm : Hb1;
            if (hh < 3) { LAS bf16_t* Hn = (hh & 1) ? Hb1 : Bm;
#pragma unroll
                for (int i = 0; i < 2; ++i) { const int idx = tid + 512 * i; *(LAS u32x4*)(Hn + (idx >> 4) * 136 + (idx & 15) * 8) = T.hreg[hh + 1][i]; } }
            const float el = __expf(ACS[hh * 64 + l]), Dh = a.in[I_SSDD][L * 8 + g * 4 + hh];
#pragma unroll
            for (int i = 0; i < 2; ++i) {
                const int prow = 32 * (w & 1) + pg8::perm32(16 * i + r);
                f32x4 ad = {0.f, 0.f, 0.f, 0.f}, ao = {0.f, 0.f, 0.f, 0.f};
#pragma unroll
                for (int ks = 0; ks < 2; ++ks) ad = mma(ldsfrag(XT, hh * 64 + prow, 72, 32 * ks + 8 * q), ldsfrag(Mh, hh * 64 + 16 * tl + r, 72, 32 * ks + 8 * q), ad);
#pragma unroll
                for (int ks = 0; ks < 4; ++ks) ao = mma(ldsfrag(Hc, prow, 136, 32 * ks + 8 * q), ldsfrag(Cm, 16 * tl + r, 136, 32 * ks + 8 * q), ao);
                const int p0 = hh * 64 + 32 * (w & 1) + 8 * q + 4 * i;
                const f32x4 zr = unpack4((u32x2){i ? T.zreg[hh].z : T.zreg[hh].x, i ? T.zreg[hh].w : T.zreg[hh].y}); f32x4 yv;
#pragma unroll
                for (int jj = 0; jj < 4; ++jj) { const float xv = bf2f(XT[(p0 + jj) * 72 + l]); yv[jj] = (ad[jj] + ao[jj] * el + Dh * xv) * zr[jj] * rcpf_(1.f + __expf(-zr[jj])); }
                yr[hh][i] = yv; ss += (yv[0] * yv[0] + yv[1] * yv[1]) + (yv[2] * yv[2] + yv[3] * yv[3]);
            }
            if (hh < 3) __syncthreads();
        }
        ss += __shfl_xor(ss, 16); ss += __shfl_xor(ss, 32);
        if (q == 0) red[w * 16 + r] = ss;
        __syncthreads();
        const float rstd = __frsqrt_rn((red[w * 16 + r] + red[(w ^ 1) * 16 + r]) * (1.f / 256.f) + EPS);
#pragma unroll
        for (int hh = 0; hh < 4; ++hh) {
            const int p0 = hh * 64 + 32 * (w & 1) + 8 * q; u32x2 pk[2];
#pragma unroll
            for (int i = 0; i < 2; ++i) { const f32x4 nw = *(const f32x4*)(a.in[I_SSDN] + L * 512 + g * 256 + p0 + 4 * i); pk[i] = pack4(yr[hh][i] * rstd * nw); }
            *(u32x4*)(Pz + (hh >> 1) * 16384 + l * 256 + ((hh & 1) * 64 + 32 * (w & 1) + 8 * q) * 2) = (u32x4){pk[0].x, pk[0].y, pk[1].x, pk[1].y};
        }
    }
}
template <int MODE>
__device__ __forceinline__ void ssd_phase(LAS unsigned char* lds, const Args& a, int L) {
    if (MODE == 1) {
        SsdIn cur, nxt; SsdLate late;
        int it = blockIdx.x;
        if (it < 512) ssd_load<MODE>(a, it, cur);
        for (; it < 512; it += gridDim.x) {
            const int itn = it + gridDim.x;
            ssd_late<MODE>(a, L, it, late);
            if (itn < 512) ssd_load<MODE>(a, itn, nxt);
            __syncthreads();
            ssd_compute<MODE>(lds, a, L, it, cur, late);
            cur = nxt;
        }
    } else {
        bool first = true;
        for (int it = blockIdx.x; it < 512; it += gridDim.x) {
            SsdIn cur; SsdLate late;
            ssd_load<MODE>(a, it, cur);
            ssd_late<MODE>(a, L, it, late);
            first = false;
            ssd_compute<MODE>(lds, a, L, it, cur, late);
        }
    }
}

struct S5In { bf16x8 uf[4]; u32x2 uv[4]; f32x2 x0; };
struct S5Par { bf16x8 bb[8], cmf[4]; f32x2 ab; f32x4 dv; };
template <int MODE>
__device__ __forceinline__ void s5_par(const Args& a, int L, int g, S5Par& Q) {
    const int lane = threadIdx.x & 63, r = lane & 15, q = lane >> 4;
    const unsigned char* pb = a.ws + WS_S5P + (size_t)L * S5P_STRIDE;
    Q.ab = ((const f32x2*)(pb + S5P_ABAR))[g * 64 + lane];
#pragma unroll
    for (int nt = 0; nt < 8; ++nt) Q.bb[nt] = *(const bf16x8*)((const bf16_t*)(pb + S5P_BBP) + (size_t)(g * 128 + 16 * nt + r) * 32 + 8 * q);
    if (MODE == 3) {
#pragma unroll
        for (int ks = 0; ks < 4; ++ks) Q.cmf[ks] = *(const bf16x8*)((const bf16_t*)(pb + S5P_CM) + (size_t)(g * 16 + r) * 128 + 32 * ks + 8 * q);
        Q.dv = *(const f32x4*)(a.in[I_S5D] + L * 512 + g * 16 + 4 * q);
    }
}
template <int MODE>
__device__ __forceinline__ void s5_load(const Args& a, int it, S5In& R) {
    const int tid = threadIdx.x, lane = tid & 63, w = tid >> 6, r = lane & 15, q = lane >> 4;
    const int b = it >> 9, c = (it >> 2) & 127, g = (it & 3) * 8 + w;
    const unsigned char* P = a.ws + WS_PROJ + (size_t)(b * 128 + c) * PT_CS + (size_t)(CT_U + (it & 3)) * 16384 + (w * 16) * 2;
#pragma unroll
    for (int sc = 0; sc < 4; ++sc) {
        R.uf[sc] = (bf16x8){0, 0, 0, 0, 0, 0, 0, 0};
        if (q < 2) R.uf[sc] = *(const bf16x8*)(P + (sc * 16 + r) * 256 + (8 * q) * 2);
        if (MODE == 3) R.uv[sc] = *(const u32x2*)(P + (sc * 16 + r) * 256 + (4 * q) * 2);
    }
    if (MODE == 3) R.x0 = *((const f32x2*)(a.ws + WS_S5X) + ((size_t)(b * 128 + c) * 32 + g) * 64 + lane);
}
template <int MODE>
__device__ __forceinline__ void s5_compute(LAS unsigned char* lds, const Args& a, int it, const S5In& R, const S5Par& Q) {
    const int tid = threadIdx.x, lane = tid & 63, w = tid >> 6, r = lane & 15, q = lane >> 4;
    const int b = it >> 9, c = (it >> 2) & 127, g = (it & 3) * 8 + w;
    const size_t row0 = (size_t)b * SEQ + c * 64;
    LAS float* BU = (LAS float*)(lds + w * 12800);
    LAS bf16_t* Xs = (LAS bf16_t*)(lds + w * 12800 + 8448);
    float xr = 0.f, xi = 0.f;
    if (MODE == 3) { xr = R.x0.x; xi = R.x0.y; }
#pragma unroll
    for (int sc = 0; sc < 4; ++sc) {
        const int t0 = sc * 16;
#pragma unroll
        for (int nt = 0; nt < 8; ++nt) { const f32x4 acc = mma(Q.bb[nt], R.uf[sc], (f32x4){0.f, 0.f, 0.f, 0.f}); *(LAS f32x4*)(BU + r * 132 + 16 * nt + 4 * q) = acc; }
        asm volatile("s_waitcnt lgkmcnt(0)" ::: "memory");
#pragma unroll
        for (int tt = 0; tt < 16; ++tt) {
            const float bur = BU[tt * 132 + lane], bui = BU[tt * 132 + 64 + lane];
            const float nr = Q.ab.x * xr - Q.ab.y * xi + bur, ni = Q.ab.x * xi + Q.ab.y * xr + bui;
            xr = nr; xi = ni;
            if (MODE == 3) *(LAS unsigned*)(Xs + tt * 136 + 2 * lane) = cvt_pk_bf16(xr, xi);
        }
        asm volatile("s_waitcnt lgkmcnt(0)" ::: "memory");
        if (MODE == 3) {
            f32x4 y = {0.f, 0.f, 0.f, 0.f};
#pragma unroll
            for (int ks = 0; ks < 4; ++ks) y = mma(Q.cmf[ks], ldsfrag(Xs, r, 136, 32 * ks + 8 * q), y);
            const f32x4 uv = unpack4(R.uv[sc]); f32x4 o;
#pragma unroll
            for (int jj = 0; jj < 4; ++jj) { const float yv = y[jj] + Q.dv[jj] * uv[jj]; o[jj] = yv * rcpf_(1.f + __expf(-1.5957691216057308f * (yv + 0.044715f * yv * yv * yv))); }
            *(u32x2*)(a.ws + WS_YG + (size_t)(b * 128 + c) * 65536 + (size_t)(it & 3) * 16384 + (t0 + r) * 256 + (w * 16 + 4 * q) * 2) = pack4(o);
        }
    }
    if (MODE == 1) *((f32x2*)(a.ws + WS_S5X) + ((size_t)(b * 128 + c) * 32 + g) * 64 + lane) = (f32x2){xr, xi};
}
template <int MODE>
__device__ __forceinline__ void s5_phase(LAS unsigned char* lds, const Args& a, int L) {
    S5In cur, nxt; S5Par Q;
    const int w = threadIdx.x >> 6;
    const bool gconst = (gridDim.x & 3) == 0;
    int it = blockIdx.x;
    if (it < 1024) { s5_par<MODE>(a, L, (it & 3) * 8 + w, Q); s5_load<MODE>(a, it, cur); }
    __syncthreads();
    for (; it < 1024; it += gridDim.x) {
        const int itn = it + gridDim.x;
        if (itn < 1024) s5_load<MODE>(a, itn, nxt);
        s5_compute<MODE>(lds, a, it, cur, Q);
        cur = nxt;
        if (!gconst && itn < 1024) s5_par<MODE>(a, L, (itn & 3) * 8 + w, Q);
    }
}

__device__ __forceinline__ void scan_phase(const Args& a, int L) {
    const int tid = threadIdx.x;
    if (tid < 128) {
        const int gi = blockIdx.x * 128 + tid, bh = gi >> 12, rem = gi & 4095, v = rem >> 5, k4 = (rem & 31) * 4;
        bf16_t* S = (bf16_t*)(a.ws + WS_HGS) + (size_t)bh * 128 * 16384 + (size_t)v * 128 + k4;
        const float* D = (const float*)(a.ws + WS_HGDEC) + (size_t)bh * 128 * 128 + k4;
        f32x4 st = {0.f, 0.f, 0.f, 0.f};
        for (int c0 = 0; c0 < 128; c0 += 8) {
            u32x2 loc[8]; f32x4 dc[8];
#pragma unroll
            for (int j = 0; j < 8; ++j) { loc[j] = __builtin_nontemporal_load((const u32x2*)(S + (size_t)(c0 + j) * 16384)); dc[j] = *(const f32x4*)(D + (size_t)(c0 + j) * 128); }
#pragma unroll
            for (int j = 0; j < 8; ++j) { __builtin_nontemporal_store(pack4(st), (u32x2*)(S + (size_t)(c0 + j) * 16384)); st = dc[j] * st + unpack4(loc[j]); }
        }
    } else if (tid < 256) {
        const int gi = blockIdx.x * 128 + (tid - 128), bhd = gi >> 11, b = bhd >> 3, hd = bhd & 7, rem = gi & 2047, p = rem >> 5, n4 = (rem & 31) * 4;
        bf16_t* S = (bf16_t*)(a.ws + WS_SSDS) + ((size_t)(b * 128) * 8 + hd) * 8192 + (size_t)p * 128 + n4;
        const float* D = (const float*)(a.ws + WS_SSDDEC) + (size_t)(b * 128) * 8 + hd;
        f32x4 st = {0.f, 0.f, 0.f, 0.f};
        for (int c0 = 0; c0 < 128; c0 += 8) {
            u32x2 loc[8]; float dc[8];
#pragma unroll
            for (int j = 0; j < 8; ++j) { loc[j] = __builtin_nontemporal_load((const u32x2*)(S + (size_t)(c0 + j) * 65536)); dc[j] = D[(size_t)(c0 + j) * 8]; }
#pragma unroll
            for (int j = 0; j < 8; ++j) { __builtin_nontemporal_store(pack4(st), (u32x2*)(S + (size_t)(c0 + j) * 65536)); st = st * dc[j] + unpack4(loc[j]); }
        }
    } else if (tid < 272) {
        const int gi = blockIdx.x * 16 + (tid - 256), b = gi >> 11, gp = gi & 2047;
        const f32x2 a64 = ((const f32x2*)(a.ws + WS_S5P + (size_t)L * S5P_STRIDE + S5P_A64))[gp];
        f32x2* X = (f32x2*)(a.ws + WS_S5X) + (size_t)(b * 128) * 2048 + gp;
        float xr = 0.f, xi = 0.f;
        for (int c0 = 0; c0 < 128; c0 += 8) {
            f32x2 e[8];
#pragma unroll
            for (int j = 0; j < 8; ++j) e[j] = X[(size_t)(c0 + j) * 2048];
#pragma unroll
            for (int j = 0; j < 8; ++j) { X[(size_t)(c0 + j) * 2048] = (f32x2){xr, xi}; const float nr = a64.x * xr - a64.y * xi + e[j].x, ni = a64.x * xi + a64.y * xr + e[j].y; xr = nr; xi = ni; }
        }
    }
}

#ifndef MK_MULTI
#define MK_MULTI 0
#endif
#ifndef GU_ALIGN
#define GU_ALIGN true
#endif
#ifndef WIN_ALIGN
#define WIN_ALIGN true
#endif
constexpr int PPL = 11;
constexpr int NPHASE = 1 + PPL * NLAYER - 1;
#define IN(k) (lo <= (k) && (k) < hi)
#define SEAM(k) do { if (IN(k) && IN((k) + 1)) xcd_barrier(xbar); } while (0)
template <int L, int J>
__device__ __forceinline__ void ffn_phases(LAS unsigned char* lds, const Args& a, const XcdBarrier& xbar, int lo, int hi) {
    constexpr int pb = 1 + PPL * L + 8 * J;
    constexpr bool lastL = (L + 1 == NLAYER), last = lastL && J == 1;
    unsigned char* ws = a.ws;
    bf16_t* HBc = (lastL && J == 1) ? (bf16_t*)(ws + WS_HB2) : (bf16_t*)a.out;
    if (IN(pb)) {
        pg8::Gemm g{HBc, (const bf16_t*)(ws + (J ? WS_WGU2 : WS_WGU1)), NTOK, 2 * DFF, DM, DM, DM}; pg8::StaticOrder S; S.init(NTOK, 2 * DFF, gridDim.x, blockIdx.x);
        pg8::EpiSwiGLU E{ws + WS_PROJ, HT_CS, (const float*)(ws + WS_RS)};
        pg8::gemm_phase<pg8::EpiSwiGLU, GU_ALIGN>(lds, g, S, E);
    }
    SEAM(pb);
    if (IN(pb + 1)) {
        pg8::Gemm g{(const bf16_t*)(ws + WS_PROJ), (const bf16_t*)(ws + (J ? WS_WD2 : WS_WD1)), NTOK, DM, DFF, 0, DFF, HT_CS}; pg8::StaticOrder S; S.init(NTOK, DM, gridDim.x, blockIdx.x);
        pg8::EpiNorm E{HBc, HBc, last ? a.out : nullptr, (float*)(ws + WS_RS), a.in[I_NORMG] + (size_t)(L * 6 + (J ? 5 : 1)) * DM, 0.5f, EPS, (float*)(ws + WS_XBUF), (unsigned*)(ws + WS_CNT), 4u * (3 * L + 2 * J + 1)};
        pg8::gemm_phase<pg8::EpiNorm, false, true>(lds, g, S, E);
    }
    SEAM(pb + 1);
}
template <int L>
__device__ __forceinline__ void layer_phases(LAS unsigned char* lds, const Args& a, const XcdBarrier& xbar, int lo, int hi) {
    constexpr int p0 = 1 + PPL * L;
    unsigned char* ws = a.ws;
    ffn_phases<L, 0>(lds, a, xbar, lo, hi);
    if (IN(p0 + 2)) {
        dt_pass((const bf16_t*)a.out, (const bf16_t*)(ws + WS_WDT), (const float*)(ws + WS_RS), (float*)(ws + WS_DT));
        pg8::Gemm g{(const bf16_t*)a.out, (const bf16_t*)(ws + WS_WIN), NTOK, 4096, DM, DM, DM}; pg8::StaticOrder S; S.init(NTOK, 4096, gridDim.x, blockIdx.x);
        pg8::EpiStoreTiled E{ws + WS_PROJ, PT_CS, (const float*)(ws + WS_RS)};
        pg8::gemm_phase<pg8::EpiStoreTiled, WIN_ALIGN>(lds, g, S, E);
    }
    SEAM(p0 + 2);
    if (IN(p0 + 3)) {
        if (!(a.skip & 1)) hg_phase<1>(lds, a, L);
        if (!(a.skip & 2)) ssd_phase<1>(lds, a, L);
        if (!(a.skip & 4)) s5_phase<1>(lds, a, L);
    }
    SEAM(p0 + 3);
    if (IN(p0 + 4)) scan_phase(a, L);
    SEAM(p0 + 4);
    if (IN(p0 + 5)) {
        if (!(a.skip & 1)) hg_phase<3>(lds, a, L);
        if (!(a.skip & 2)) ssd_phase<3>(lds, a, L);
        if (!(a.skip & 4)) s5_phase<3>(lds, a, L);
    }
    SEAM(p0 + 5);
    if (IN(p0 + 6)) {
        pg8::Gemm g{(const bf16_t*)(ws + WS_YG), (const bf16_t*)(ws + WS_WGLU), NTOK, 512, 512, 0, 512, 65536}; pg8::StaticOrder S; S.init(NTOK, 512, gridDim.x, blockIdx.x);
        pg8::EpiGlu E{(const bf16_t*)(ws + WS_YG), a.in[I_GLUB] + L * 512, ws + WS_PROJ, 512, PT_CS, CT_U};
        pg8::gemm_phase<pg8::EpiGlu, false, true>(lds, g, S, E);
    }
    SEAM(p0 + 6);
    if (IN(p0 + 7)) {
        pg8::Gemm g{(const bf16_t*)(ws + WS_PROJ), (const bf16_t*)(ws + WS_WOUT), NTOK, DM, DMIX, 0, DMIX, PT_CS}; pg8::StaticOrder S; S.init(NTOK, DM, gridDim.x, blockIdx.x);
        pg8::EpiNorm E{(const bf16_t*)a.out, (L + 1 == NLAYER) ? (bf16_t*)(ws + WS_HB2) : (bf16_t*)a.out, nullptr, (float*)(ws + WS_RS), a.in[I_NORMG] + (size_t)(L * 6 + 3) * DM, 1.0f, EPS, (float*)(ws + WS_XBUF), (unsigned*)(ws + WS_CNT), 4u * (3 * L + 2)};
        pg8::gemm_phase<pg8::EpiNorm, false, true>(lds, g, S, E);
    }
    SEAM(p0 + 7);
    ffn_phases<L, 1>(lds, a, xbar, lo, hi);
    if (L + 1 < NLAYER) {
        if (IN(p0 + 10)) convert_weights(lds, a, L + 1);
        SEAM(p0 + 10);
    }
}
__global__ void __launch_bounds__(512, 2) mega_fwd(Args a) {
    extern __shared__ __attribute__((aligned(16))) unsigned char lds_raw[];
    LAS unsigned char* lds = (LAS unsigned char*)lds_raw;
    cg::grid_group grid = cg::this_grid();
    const int lo = a.ph_lo, hi = a.ph_hi;
    volatile LAS unsigned* xst = (volatile LAS unsigned*)(lds + 131072);
    if (threadIdx.x < 4) xst[threadIdx.x] = 0u;
    __syncthreads();
    const XcdBarrier xbar = xcd_barrier_post((unsigned*)(a.ws + WS_BAR), xst);
    if (IN(0)) {
        setup_params(a);
        convert_weights(lds, a, 0);
        r0_pass(a.in[I_X], (bf16_t*)a.out, (float*)(a.ws + WS_RS));
    }
    if (lo < 0) { asm volatile("s_waitcnt vmcnt(0) lgkmcnt(0)" ::: "memory"); grid.sync(); }
    if (IN(0) && IN(1)) xcd_barrier(xbar);
    layer_phases<0>(lds, a, xbar, lo, hi);
    layer_phases<1>(lds, a, xbar, lo, hi);
}
#undef IN
#undef SEAM

extern "C" void kernel_launch(void* const* d_in, const int* in_sizes, int n_in, void* d_out, int out_size, void* d_ws, size_t ws_size, hipStream_t stream) {
    static int grid = 0;
    if (grid == 0) {
        int dev = 0, cus = 0, per_cu = 0;
        hipGetDevice(&dev);
        hipDeviceGetAttribute(&cus, hipDeviceAttributeMultiprocessorCount, dev);
        if (hipFuncSetAttribute((const void*)mega_fwd, hipFuncAttributeMaxDynamicSharedMemorySize, LDS_BYTES) != hipSuccess) fprintf(stderr, "kernel_launch: hipFuncSetAttribute failed\n");
        if (hipOccupancyMaxActiveBlocksPerMultiprocessor(&per_cu, (const void*)mega_fwd, 512, LDS_BYTES) != hipSuccess || per_cu < 1) { fprintf(stderr, "kernel_launch: occupancy query gives %d\n", per_cu); per_cu = 1; }
        (void)hipGetLastError();
        grid = cus;
        if (n_in != 25 || ws_size < 256 * MiB) fprintf(stderr, "kernel_launch: unexpected n_in %d / ws %zu\n", n_in, ws_size);
    }
    (void)hipMemsetAsync((unsigned char*)d_ws + WS_BAR, 0, 49152, stream);
    Args a{};
    for (int i = 0; i < 25; ++i) a.in[i] = (const float*)d_in[i];
    a.out = (float*)d_out; a.ws = (unsigned char*)d_ws;
#if MK_MULTI
    for (int p = 0; p < NPHASE; ++p) { a.ph_lo = p; a.ph_hi = p + 1; hipLaunchKernelGGL(mega_fwd, dim3(grid), dim3(512), LDS_BYTES, stream, a); }
#else
#ifndef DBG_PH_HI
#define DBG_PH_HI NPHASE
#endif
    a.ph_lo = 0; a.ph_hi = DBG_PH_HI;
    void* args[] = {&a};
    hipError_t e = hipLaunchCooperativeKernel((const void*)mega_fwd, dim3(grid), dim3(512), args, LDS_BYTES, stream);
    if (e != hipSuccess) fprintf(stderr, "cooperative launch failed: %s (grid %d)\n", hipGetErrorString(e), grid);
#ifdef PROBE_LIST
    { const int pl[] = PROBE_LIST;
      for (int p : pl) { a.ph_lo = p & 255; a.ph_hi = (p & 255) + 1; a.skip = p >> 8; hipLaunchKernelGGL(mega_fwd, dim3(grid), dim3(512), LDS_BYTES, stream, a); } }
#endif
#endif
}
```

```cpp
#include <hip/hip_runtime.h>
#include <hip/hip_cooperative_groups.h>
#include <cstdio>
#include <cstdint>
namespace cg = cooperative_groups;

#define LAS __attribute__((address_space(3)))
typedef unsigned short bf16_t;
typedef short bf16x8 __attribute__((ext_vector_type(8)));
typedef float f32x4 __attribute__((ext_vector_type(4)));
typedef float f32x2 __attribute__((ext_vector_type(2)));
typedef unsigned u32x4 __attribute__((ext_vector_type(4)));
typedef unsigned u32x2 __attribute__((ext_vector_type(2)));

__device__ __forceinline__ float bf2f(unsigned v) { return __builtin_bit_cast(float, v << 16); }
typedef __bf16 bf16x2_t __attribute__((ext_vector_type(2)));
__device__ __forceinline__ unsigned cvt_pk_bf16(float lo, float hi) { const f32x2 v = {lo, hi}; const bf16x2_t b = __builtin_convertvector(v, bf16x2_t); return __builtin_bit_cast(unsigned, b); }
__device__ __forceinline__ bf16_t f2bf(float f) { return (bf16_t)(cvt_pk_bf16(f, 0.f) & 0xffffu); }
__device__ __forceinline__ u32x2 pack4(f32x4 v) { u32x2 o; o.x = cvt_pk_bf16(v[0], v[1]); o.y = cvt_pk_bf16(v[2], v[3]); return o; }
__device__ __forceinline__ f32x4 unpack4(u32x2 u) { f32x4 v; v[0] = bf2f(u.x & 0xffffu); v[1] = bf2f(u.x >> 16); v[2] = bf2f(u.y & 0xffffu); v[3] = bf2f(u.y >> 16); return v; }
__device__ __forceinline__ float sigmoidf_(float x) { return 1.0f / (1.0f + __expf(-x)); }
__device__ __forceinline__ float siluf_(float x) { return x * sigmoidf_(x); }
__device__ __forceinline__ float wave_sum(float v) {
#pragma unroll
    for (int o = 1; o < 64; o <<= 1) v += __shfl_xor(v, o);
    return v;
}
__device__ __forceinline__ f32x4 mma(bf16x8 qf, bf16x8 pf, f32x4 acc) { return __builtin_amdgcn_mfma_f32_16x16x32_bf16(qf, pf, acc, 0, 0, 0); }
__device__ __forceinline__ bf16x8 ldsfrag(const LAS bf16_t* base, int row, int stride, int kk) { return *(const LAS bf16x8*)(base + row * stride + kk); }

#ifndef PG8_WGM
#define PG8_WGM 8
#endif
namespace pg8 {
constexpr int BM = 256, BK = 64, HALF = 128, HTB = HALF * BK * 2, STAGE_BYTES = 8 * HTB, NXCD = 8, WGM = PG8_WGM;
__host__ __device__ __forceinline__ int lds_byte(int r, int c) { const int st = (r >> 4) * 2 + (c >> 5), rr = r & 15, cc = c & 31, ob = rr * 64 + cc * 2; return st * 1024 + (ob ^ (((ob >> 9) & 1) << 5)); }
__host__ __device__ __forceinline__ void stage_rc(int b, int& R, int& C) { const int st = b / 1024, sb = b % 1024, swz = sb ^ (((sb >> 9) & 1) << 5); R = (st >> 1) * 16 + swz / 64; C = (st & 1) * 32 + (swz % 64) / 2; }
__host__ __device__ __forceinline__ int perm32(int rho) { const int n = rho >> 4, i = rho & 15; return 8 * (i >> 2) + 4 * n + (i & 3); }
struct Unit { int pm, pn; };
struct Gemm { const bf16_t* A; const bf16_t* Bt; int M, N, K, lda, ldb; size_t csA = 0; };
struct StaticOrder {
    int nM, nN, nwg, G, c;
    __host__ __device__ void init(int M, int N, int G_, int c_) { nM = M / BM; nN = N / BM; nwg = nM * nN; G = G_; c = c_; }
    __host__ __device__ bool next(int i, Unit& u) const {
        const long L = (long)i * G + c; if (L >= nwg) return false;
        int wgid = (int)L; { const int q = nwg / NXCD, r = nwg % NXCD, xcd = wgid % NXCD, off = wgid / NXCD; wgid = (xcd < r ? xcd * (q + 1) : r * (q + 1) + (xcd - r) * q) + off; }
        const int nig = WGM * nN, gid = wgid / nig, fm = gid * WGM, gsz = (nM - fm) < WGM ? (nM - fm) : WGM;
        u.pm = fm + ((wgid % nig) % gsz); u.pn = (wgid % nig) / gsz; return true;
    }
};
template <class Epi, bool ALIGN_EPI, bool TILED_A = false>
__device__ __forceinline__ void gemm_phase(LAS unsigned char* lds, const Gemm g, const StaticOrder& S, const Epi& E) {
    const int tid = threadIdx.x, wid = __builtin_amdgcn_readfirstlane(tid >> 6), lane = tid & 63, wr = wid >> 2, wc = wid & 3, fr = lane & 15, fq = lane >> 4;
    const int K = g.K, nt = K / BK;
    unsigned voffA[2], voffB[2];
#pragma unroll
    for (int i = 0; i < 2; ++i) { int R, C; stage_rc(tid * 16 + i * 8192, R, C);
        const int Rb = Epi::PERM ? ((R & ~31) + perm32(R & 31)) : R;
        voffA[i] = TILED_A ? (unsigned)((R >> 6) * (unsigned)g.csA + (R & 63) * 256 + C * 2) : (unsigned)(R * g.lda + C) * 2u; voffB[i] = (unsigned)(Rb * g.ldb + C) * 2u; }
    const size_t kstep = (size_t)(BK * 2);
    const size_t hA = TILED_A ? 2 * g.csA : (size_t)HALF * g.lda * 2, hB = (size_t)HALF * g.ldb * 2;
    const size_t tA = 2 * hA, tB = 2 * hB;
    const unsigned ldsw = (unsigned)wid * 1024u;
    const int aoff = lds_byte(wr * 64 + fr, fq * 8), boff = lds_byte(wc * 32 + fr, fq * 8);
#define PG8_SA(b, h) (((b) * 2 + (h)) * HTB)
#define PG8_SB(b, h) ((4 + (b) * 2 + (h)) * HTB)
#define PG8_STAGE(bufoff, gbase, voff) do { _Pragma("unroll") for (int _i = 0; _i < 2; ++_i) \
        __builtin_amdgcn_global_load_lds((const unsigned*)((const char*)(gbase) + (voff)[_i]), (LAS unsigned*)(lds + (bufoff) + ldsw + _i * 8192), 16, 0, 0); } while (0)
#define PG8_LDA(dst, b, h) do { _Pragma("unroll") for (int m = 0; m < 4; ++m) _Pragma("unroll") for (int k = 0; k < 2; ++k) dst[m][k] = *(const LAS bf16x8*)(lds + PG8_SA(b, h) + aoff + m * 2048 + k * 1024); } while (0)
#define PG8_LDB(dst, b, h) do { _Pragma("unroll") for (int n = 0; n < 2; ++n) _Pragma("unroll") for (int k = 0; k < 2; ++k) dst[n][k] = *(const LAS bf16x8*)(lds + PG8_SB(b, h) + boff + n * 2048 + k * 1024); } while (0)
#define PG8_MMA(ai, bj, At, Bt) do { __builtin_amdgcn_s_setprio(1); _Pragma("unroll") for (int m = 0; m < 4; ++m) _Pragma("unroll") for (int n = 0; n < 2; ++n) _Pragma("unroll") for (int k = 0; k < 2; ++k) \
        acc[ai][bj][m][n] = __builtin_amdgcn_mfma_f32_16x16x32_bf16(Bt[n][k], At[m][k], acc[ai][bj][m][n], 0, 0, 0); __builtin_amdgcn_s_setprio(0); } while (0)
#define PG8_WAIT_V(n) asm volatile("s_waitcnt vmcnt(" #n ")" ::: "memory")
#define PG8_WAIT_L(n) asm volatile("s_waitcnt lgkmcnt(" #n ")" ::: "memory")
#define PG8_BAR __builtin_amdgcn_s_barrier()
#define PG8_SCHED __builtin_amdgcn_sched_barrier(0)
    Unit cur, nxt; int ui = 0;
    if (!S.next(0, cur)) return;
    f32x4 acc[2][2][4][2];
#pragma unroll
    for (int a = 0; a < 2; ++a)
#pragma unroll
        for (int b = 0; b < 2; ++b)
#pragma unroll
            for (int m = 0; m < 4; ++m)
#pragma unroll
                for (int n = 0; n < 2; ++n) acc[a][b][m][n] = (f32x4){0.f, 0.f, 0.f, 0.f};
    bf16x8 At[4][2], B0[2][2], B1[2][2];
    const char* cA = (const char*)g.A + (size_t)cur.pm * tA; const char* cB = (const char*)g.Bt + (size_t)cur.pn * tB;
    PG8_STAGE(PG8_SB(0, 0), cB, voffB); PG8_STAGE(PG8_SB(0, 1), cB + hB, voffB); PG8_STAGE(PG8_SA(0, 0), cA, voffA); PG8_STAGE(PG8_SA(0, 1), cA + hA, voffA);
    if (wr == 1) PG8_BAR;
    PG8_WAIT_V(2); PG8_BAR;
    PG8_STAGE(PG8_SB(1, 0), cB + kstep, voffB); PG8_STAGE(PG8_SA(1, 0), cA + kstep, voffA); PG8_STAGE(PG8_SB(1, 1), cB + hB + kstep, voffB);
    PG8_WAIT_V(6); PG8_BAR;
    for (;;) {
        const bool has_next = S.next(ui + 1, nxt);
        const char* nA = has_next ? (const char*)g.A + (size_t)nxt.pm * tA : cA; const char* nB = has_next ? (const char*)g.Bt + (size_t)nxt.pn * tB : cB;
        for (int t = 0; t < nt; t += 2) {
            const bool last = (t == nt - 2);
            const char* a1 = TILED_A ? cA + (size_t)(t >> 1) * 16384 + 128 : cA + (size_t)(t + 1) * kstep;
            const char* a2 = last ? nA : (TILED_A ? cA + (size_t)((t + 2) >> 1) * 16384 : cA + (size_t)(t + 2) * kstep); const char* b2 = last ? nB : cB + (size_t)(t + 2) * kstep;
            const char* a3 = a2 + kstep; const char* b3 = b2 + kstep;
            PG8_LDB(B0, 0, 0); PG8_LDB(B1, 0, 1); PG8_SCHED; PG8_LDA(At, 0, 0); PG8_STAGE(PG8_SA(1, 1), a1 + hA, voffA);
            PG8_WAIT_V(8); PG8_WAIT_L(0); PG8_BAR; PG8_MMA(0, 0, At, B0); PG8_MMA(0, 1, At, B1); PG8_BAR; PG8_SCHED;
            PG8_LDA(At, 0, 1); PG8_STAGE(PG8_SB(0, 0), b2, voffB); PG8_STAGE(PG8_SB(0, 1), b2 + hB, voffB); PG8_STAGE(PG8_SA(0, 0), a2, voffA);
            PG8_WAIT_V(8); PG8_WAIT_L(0); PG8_BAR; PG8_MMA(1, 0, At, B0); PG8_MMA(1, 1, At, B1); PG8_BAR; PG8_SCHED;
            PG8_LDB(B0, 1, 0); PG8_LDB(B1, 1, 1); PG8_SCHED; PG8_LDA(At, 1, 0); PG8_STAGE(PG8_SA(0, 1), a2 + hA, voffA);
            PG8_WAIT_V(8); PG8_WAIT_L(0); PG8_BAR; PG8_MMA(0, 0, At, B0); PG8_MMA(0, 1, At, B1); PG8_BAR; PG8_SCHED;
            PG8_LDA(At, 1, 1); PG8_STAGE(PG8_SB(1, 0), b3, voffB); PG8_STAGE(PG8_SB(1, 1), b3 + hB, voffB); PG8_STAGE(PG8_SA(1, 0), a3, voffA);
            PG8_WAIT_V(8); PG8_WAIT_L(0); PG8_BAR; PG8_MMA(1, 0, At, B0); PG8_MMA(1, 1, At, B1); PG8_BAR; PG8_SCHED;
        }
        if constexpr (ALIGN_EPI) { if (wr == 0) PG8_BAR; }
        if constexpr (!Epi::AFTER_DRAIN) E(acc, cur, wr, wc, fr, fq);
        if (!has_next) break;
#pragma unroll
        for (int a = 0; a < 2; ++a)
#pragma unroll
            for (int b = 0; b < 2; ++b)
#pragma unroll
                for (int m = 0; m < 4; ++m)
#pragma unroll
                    for (int n = 0; n < 2; ++n) acc[a][b][m][n] = (f32x4){0.f, 0.f, 0.f, 0.f};
        cur = nxt; cA = nA; cB = nB; ++ui;
        if constexpr (ALIGN_EPI) { if (wr == 1) PG8_BAR; }
    }
    PG8_WAIT_V(0);
    if constexpr (!ALIGN_EPI) { if (wr == 0) PG8_BAR; }
    PG8_BAR;
    if constexpr (Epi::AFTER_DRAIN) E.fused(acc, cur, wr, wc, fr, fq, lds, wid, lane);
#undef PG8_SA
#undef PG8_SB
#undef PG8_STAGE
#undef PG8_LDA
#undef PG8_LDB
#undef PG8_MMA
#undef PG8_WAIT_V
#undef PG8_WAIT_L
#undef PG8_BAR
#undef PG8_SCHED
}

struct EpiStore {
    static constexpr bool AFTER_DRAIN = false, PERM = true;
    bf16_t* O; int ldc; const float* RS;
    __device__ __forceinline__ void operator()(const f32x4 (&acc)[2][2][4][2], const Unit& u, int wr, int wc, int fr, int fq) const {
#pragma unroll
        for (int ai = 0; ai < 2; ++ai)
#pragma unroll
            for (int m = 0; m < 4; ++m) {
                const int row = u.pm * BM + ai * HALF + wr * 64 + m * 16 + fr;
                const float rs = RS[row];
                bf16_t* rowp = O + (size_t)row * ldc + u.pn * BM + wc * 32 + 8 * fq;
#pragma unroll
                for (int bj = 0; bj < 2; ++bj) { const u32x2 lo = pack4(acc[ai][bj][m][0] * rs), hi = pack4(acc[ai][bj][m][1] * rs);
                    *(u32x4*)(rowp + bj * HALF) = (u32x4){lo.x, lo.y, hi.x, hi.y}; }
            }
    }
};
struct EpiStoreTiled {
    static constexpr bool AFTER_DRAIN = false, PERM = true;
    unsigned char* base; size_t cs; const float* RS;
    __device__ __forceinline__ void operator()(const f32x4 (&acc)[2][2][4][2], const Unit& u, int wr, int wc, int fr, int fq) const {
#pragma unroll
        for (int ai = 0; ai < 2; ++ai)
#pragma unroll
            for (int m = 0; m < 4; ++m) {
                const int row = u.pm * BM + ai * HALF + wr * 64 + m * 16 + fr;
                const float rs = RS[row];
                unsigned char* rowp = base + (size_t)(row >> 6) * cs + (size_t)(2 * u.pn) * 16384 + (row & 63) * 256 + (wc * 32 + 8 * fq) * 2;
#pragma unroll
                for (int bj = 0; bj < 2; ++bj) { const u32x2 lo = pack4(acc[ai][bj][m][0] * rs), hi = pack4(acc[ai][bj][m][1] * rs);
                    *(u32x4*)(rowp + bj * 16384) = (u32x4){lo.x, lo.y, hi.x, hi.y}; }
            }
    }
};
struct EpiSwiGLU {
    static constexpr bool AFTER_DRAIN = false, PERM = true;
    unsigned char* Hbase; size_t cs; const float* RS;
    __device__ __forceinline__ void operator()(const f32x4 (&acc)[2][2][4][2], const Unit& u, int wr, int wc, int fr, int fq) const {
#pragma unroll
        for (int ai = 0; ai < 2; ++ai)
#pragma unroll
            for (int m = 0; m < 4; ++m) {
                const int row = u.pm * BM + ai * HALF + wr * 64 + m * 16 + fr;
                const float rs = RS[row];
                unsigned char* rowp = Hbase + (size_t)(row >> 6) * cs + (size_t)u.pn * 16384 + (row & 63) * 256 + (wc * 32 + 8 * fq) * 2;
                u32x2 pk[2];
#pragma unroll
                for (int n = 0; n < 2; ++n) {
                    const f32x4 gt = acc[ai][0][m][n] * rs, up = acc[ai][1][m][n] * rs; f32x4 v;
#pragma unroll
                    for (int j = 0; j < 4; ++j) v[j] = gt[j] * __builtin_amdgcn_rcpf(1.f + __expf(-gt[j])) * up[j];
                    pk[n] = pack4(v);
                }
                *(u32x4*)rowp = (u32x4){pk[0].x, pk[0].y, pk[1].x, pk[1].y};
            }
    }
};
struct EpiGlu {
    static constexpr bool AFTER_DRAIN = false, PERM = true;
    const bf16_t* YG; const float* bias; unsigned char* Obase; int ldy; size_t cs; int ct0;
    __device__ __forceinline__ void operator()(const f32x4 (&acc)[2][2][4][2], const Unit& u, int wr, int wc, int fr, int fq) const {
#pragma unroll
        for (int ai = 0; ai < 2; ++ai)
#pragma unroll
            for (int m = 0; m < 4; ++m) {
                const size_t row = (size_t)(u.pm * BM + ai * HALF + wr * 64 + m * 16 + fr);
#pragma unroll
                for (int bj = 0; bj < 2; ++bj) {
                    const int c = u.pn * BM + bj * HALF + wc * 32 + 8 * fq;
                    const u32x4 yr = *(const u32x4*)((const unsigned char*)YG + (row >> 6) * 65536 + (size_t)(2 * u.pn + bj) * 16384 + (row & 63) * 256 + (wc * 32 + 8 * fq) * 2);
                    u32x2 pk[2];
#pragma unroll
                    for (int n = 0; n < 2; ++n) {
                        const f32x4 yg = unpack4((u32x2){n ? yr.z : yr.x, n ? yr.w : yr.y});
                        const f32x4 bb = *(const f32x4*)(bias + c + 4 * n); f32x4 v;
#pragma unroll
                        for (int j = 0; j < 4; ++j) v[j] = yg[j] * __builtin_amdgcn_rcpf(1.f + __expf(-(acc[ai][bj][m][n][j] + bb[j])));
                        pk[n] = pack4(v);
                    }
                    *(u32x4*)(Obase + (size_t)(row >> 6) * cs + (size_t)(ct0 + 2 * u.pn + bj) * 16384 + (row & 63) * 256 + (wc * 32 + 8 * fq) * 2) = (u32x4){pk[0].x, pk[0].y, pk[1].x, pk[1].y};
                }
            }
    }
};
#ifndef EPI_HB
#define EPI_HB 2
#endif
struct EpiNorm {
    static constexpr bool AFTER_DRAIN = true, PERM = true; static constexpr int HB = EPI_HB;
    const bf16_t* Hin; bf16_t* Hout; float* OutF; float* RSout; const float* gpost; float scale, eps; float* xbuf; unsigned* cnt; unsigned expect;
    __device__ __forceinline__ void operator()(const f32x4 (&)[2][2][4][2], const Unit&, int, int, int, int) const {}
    __device__ __forceinline__ void exchange(int e, const float (&ssq)[2][4], const Unit& u, int wr, int wc, int fr, int fq, LAS unsigned char* lds, float (&rs)[2][4]) const {
        LAS float* Pl = (LAS float*)lds;
        LAS float* Sl = (LAS float*)(lds + 4096);
        const int tid = threadIdx.x;
#pragma unroll
        for (int ai = 0; ai < 2; ++ai)
#pragma unroll
            for (int m = 0; m < 4; ++m) { float s = ssq[ai][m]; s += __shfl_xor(s, 16); s += __shfl_xor(s, 32); if (fq == 0) Pl[(ai * HALF + wr * 64 + m * 16 + fr) * 4 + wc] = s; }
        __syncthreads();
        float* xb = xbuf + (size_t)e * 65536 + (size_t)u.pm * 1024;
        unsigned* cw = cnt + (e * 64 + u.pm) * 64;
        if (tid < 256) { const f32x4 p = *(const LAS f32x4*)(Pl + tid * 4); __hip_atomic_store(xb + tid * 4 + u.pn, (p[0] + p[1]) + (p[2] + p[3]), __ATOMIC_RELAXED, __HIP_MEMORY_SCOPE_AGENT); }
        asm volatile("s_waitcnt vmcnt(0)" ::: "memory");
        __syncthreads();
        if (tid == 0) {
            __hip_atomic_fetch_add(cw, 1u, __ATOMIC_RELAXED, __HIP_MEMORY_SCOPE_AGENT);
            unsigned sp = 0;
            while (__hip_atomic_load(cw, __ATOMIC_RELAXED, __HIP_MEMORY_SCOPE_AGENT) < expect) { if (++sp > (1u << 24)) break; }
        }
        __syncthreads();
        if (tid < 256) {
            float t = 0.f;
#pragma unroll
            for (int j = 0; j < 4; ++j) t += __hip_atomic_load(xb + tid * 4 + j, __ATOMIC_RELAXED, __HIP_MEMORY_SCOPE_AGENT);
            Sl[tid] = __frsqrt_rn(t * (1.f / 1024.f) + eps);
        }
        __syncthreads();
#pragma unroll
        for (int ai = 0; ai < 2; ++ai)
#pragma unroll
            for (int m = 0; m < 4; ++m) rs[ai][m] = Sl[ai * HALF + wr * 64 + m * 16 + fr];
    }
    __device__ __forceinline__ void fused(f32x4 (&acc)[2][2][4][2], const Unit& u, int wr, int wc, int fr, int fq, LAS unsigned char* lds, int, int) const {
        float ssq[2][4], rs[2][4];
#pragma unroll
        for (int ai = 0; ai < 2; ++ai)
#pragma unroll
            for (int m = 0; m < 4; ++m) { float s = 0.f;
#pragma unroll
                for (int bj = 0; bj < 2; ++bj)
#pragma unroll
                    for (int n = 0; n < 2; ++n) { const f32x4 v = acc[ai][bj][m][n]; s += (v[0] * v[0] + v[1] * v[1]) + (v[2] * v[2] + v[3] * v[3]); }
                ssq[ai][m] = s; }
        const int col0 = u.pn * BM + wc * 32 + 8 * fq;
        u32x4 hreg[2][4][2];
#pragma unroll
        for (int ai = 0; ai < 2; ++ai)
#pragma unroll
            for (int m = 0; m < 4; ++m) { const bf16_t* hp = Hin + (size_t)(u.pm * BM + ai * HALF + wr * 64 + m * 16 + fr) * 1024 + col0;
#pragma unroll
                for (int bj = 0; bj < 2; ++bj) hreg[ai][m][bj] = *(const u32x4*)(hp + bj * HALF); }
        f32x4 gp[2][2];
#pragma unroll
        for (int bj = 0; bj < 2; ++bj)
#pragma unroll
            for (int n = 0; n < 2; ++n) gp[bj][n] = *(const f32x4*)(gpost + col0 + bj * HALF + 4 * n);
        exchange(0, ssq, u, wr, wc, fr, fq, lds, rs);
#pragma unroll
        for (int ai = 0; ai < 2; ++ai)
#pragma unroll
            for (int m = 0; m < 4; ++m) {
                const size_t roff = (size_t)(u.pm * BM + ai * HALF + wr * 64 + m * 16 + fr) * 1024 + col0;
                const float k = scale * rs[ai][m]; float s = 0.f;
#pragma unroll
                for (int bj = 0; bj < 2; ++bj) {
                    const u32x4 hr = hreg[ai][m][bj]; u32x2 pk[2];
#pragma unroll
                    for (int n = 0; n < 2; ++n) { const f32x4 v = unpack4((u32x2){n ? hr.z : hr.x, n ? hr.w : hr.y}) + (acc[ai][bj][m][n] * k) * gp[bj][n];
                        if (OutF) *(f32x4*)(OutF + roff + bj * HALF + 4 * n) = v; else pk[n] = pack4(v);
                        s += (v[0] * v[0] + v[1] * v[1]) + (v[2] * v[2] + v[3] * v[3]); }
                    if (!OutF) *(u32x4*)(Hout + roff + bj * HALF) = (u32x4){pk[0].x, pk[0].y, pk[1].x, pk[1].y};
                }
                ssq[ai][m] = s;
            }
        if (OutF) return;
        exchange(1, ssq, u, wr, wc, fr, fq, lds, rs);
        if (u.pn == 0 && wc == 0 && fq == 0) {
#pragma unroll
            for (int ai = 0; ai < 2; ++ai)
#pragma unroll
                for (int m = 0; m < 4; ++m) RSout[u.pm * BM + ai * HALF + wr * 64 + m * 16 + fr] = rs[ai][m];
        }
    }
};
}

constexpr int NTOK = 16384, SEQ = 8192, DM = 1024, DFF = 2816, DIN = 4104, DMIX = 1536, NLAYER = 2;
constexpr int PJ = 4160;
constexpr int PQ = 0, PZ = 512, PU = 1024, PF = 1536, PI = 2048, PG = 2560, PX = 3072;
constexpr size_t PT_CS = 32 * 16384 + 256;
constexpr size_t HT_CS = 22 * 16384 + 256;
constexpr int CT_Q = 0, CT_Z = 4, CT_U = 8, CT_F = 12, CT_I = 16, CT_G = 20, CT_X = 24;
constexpr float EPS = 1e-6f;
constexpr size_t MiB = (size_t)1 << 20;
constexpr size_t WS_BAR = 8192;
constexpr size_t WS_CNT = 24576;
constexpr size_t WS_LB = 0;
constexpr size_t WS_S5P = 65536, S5P_STRIDE = 458752;
constexpr size_t S5P_ABAR = 0, S5P_A64 = 16384, S5P_BBP = 32768, S5P_CM = 32768 + 262144;
constexpr size_t WS_WGU1 = 1 * MiB, WS_WD1 = 12 * MiB, WS_WGU2 = 35 * MiB / 2, WS_WD2 = 57 * MiB / 2, WS_WIN = 34 * MiB, WS_WOUT = 42 * MiB, WS_WGLU = 45 * MiB;
constexpr size_t WS_XN = 46 * MiB, WS_Y = 78 * MiB, WS_PROJ = 110 * MiB, WS_YG = 240 * MiB, WS_DT = 91 * MiB / 2;
constexpr size_t WS_S5X = 1 * MiB, WS_HGDEC = 5 * MiB, WS_SSDDEC = 6 * MiB, WS_HGS = WS_XN, WS_SSDS = WS_Y;
constexpr size_t WS_WDT = 983040;
constexpr size_t WS_XBUF = WS_Y;
constexpr size_t WS_RS = WS_YG;
constexpr size_t WS_HB2 = WS_XN;
constexpr int LDS_BYTES = 131072 + 1024;

struct Args { const float* in[25]; float* out; unsigned char* ws; int ph_lo, ph_hi, skip, pad; };
enum { I_X = 0, I_NORMG, I_WGATE, I_WUP, I_WDOWN, I_WIN, I_WOUT, I_LBLOG, I_GNORM, I_CONVW, I_CONVB, I_DTB, I_ALOG, I_SSDD, I_SSDN,
       I_S5ARE, I_S5AIM, I_S5BRE, I_S5BIM, I_S5CRE, I_S5CIM, I_S5D, I_S5LDT, I_GLUW, I_GLUB };

__device__ __forceinline__ void transpose_item(const float* W, int ldw, int K, bf16_t* WT, int k0, int ns0, int dr0, LAS float* scr, int lane, const float* gain = nullptr) {
#pragma unroll 8
    for (int i = 0; i < 32; ++i) { const int kk = 2 * i + (lane >> 5); const float gk = gain ? gain[k0 + kk] : 1.f; scr[kk * 33 + (lane & 31)] = __builtin_nontemporal_load(W + (size_t)(k0 + kk) * ldw + ns0 + (lane & 31)) * gk; }
    asm volatile("s_waitcnt lgkmcnt(0)" ::: "memory");
    const int c = lane & 7;
#pragma unroll
    for (int j = 0; j < 4; ++j) { const int n = (lane >> 3) + 8 * j; const LAS float* s = scr + (8 * c) * 33 + n;
        u32x4 o; o.x = cvt_pk_bf16(s[0 * 33], s[1 * 33]); o.y = cvt_pk_bf16(s[2 * 33], s[3 * 33]); o.z = cvt_pk_bf16(s[4 * 33], s[5 * 33]); o.w = cvt_pk_bf16(s[6 * 33], s[7 * 33]);
        *(u32x4*)(WT + (size_t)(dr0 + n) * K + k0 + 8 * c) = o; }
    asm volatile("s_waitcnt lgkmcnt(0)" ::: "memory");
}
__device__ __forceinline__ void convert_weights(LAS unsigned char* lds, const Args& a, int L) {
    const int tid = threadIdx.x, lane = tid & 63, w = tid >> 6;
    LAS float* scr = (LAS float*)(lds + w * 16384);
    const int gw = blockIdx.x * 8 + w, NGW = gridDim.x * 8;
    constexpr int I_GU = 16 * 88, I_D = 44 * 32, I_IN = 16 * 128, I_OUT = 24 * 32, I_GL = 8 * 16;
    constexpr int NIT = 4 * I_GU + 2 * I_D + I_IN + I_OUT + I_GL;
    unsigned char* ws = a.ws;
    for (int it = gw; it < NIT; it += NGW) {
        int r = it;
        if (r < 4 * I_GU) {
            const int mtx = r / I_GU, rr = r % I_GU, j = mtx >> 1, isup = mtx & 1;
            const int kb = rr / 88, nb = rr % 88, ns0 = 32 * nb;
            const float* W = (isup ? a.in[I_WUP] : a.in[I_WGATE]) + (size_t)(L * 2 + j) * DM * DFF;
            bf16_t* WT = (bf16_t*)(ws + (j ? WS_WGU2 : WS_WGU1));
            transpose_item(W, DFF, DM, WT, 64 * kb, ns0, (ns0 >> 7) * 256 + (ns0 & 127) + isup * 128, scr, lane, a.in[I_NORMG] + (size_t)(L * 6 + (j ? 4 : 0)) * DM); continue;
        }
        r -= 4 * I_GU;
        if (r < 2 * I_D) {
            const int j = r / I_D, rr = r % I_D, kb = rr / 32, nb = rr % 32;
            const float* W = a.in[I_WDOWN] + (size_t)(L * 2 + j) * DFF * DM;
            transpose_item(W, DM, DFF, (bf16_t*)(ws + (j ? WS_WD2 : WS_WD1)), 64 * kb, 32 * nb, 32 * nb, scr, lane); continue;
        }
        r -= 2 * I_D;
        if (r < I_IN) {
            const int kb = r / 128, nb = r % 128, dr0 = 32 * nb, seg = dr0 >> 9, o = dr0 & 511;
            const int src = seg == 0 ? 0 : seg == 1 ? 2048 : seg == 2 ? 3592 : seg == 3 ? 512 : seg == 4 ? 1024 : seg == 5 ? 1536 : seg == 6 ? 2560 : 3072;
            transpose_item(a.in[I_WIN] + (size_t)L * DM * DIN, DIN, DM, (bf16_t*)(ws + WS_WIN), 64 * kb, src + o, dr0, scr, lane, a.in[I_NORMG] + (size_t)(L * 6 + 2) * DM); continue;
        }
        r -= I_IN;
        if (r < I_OUT) { const int kb = r / 32, nb = r % 32;
            transpose_item(a.in[I_WOUT] + (size_t)L * DMIX * DM, DM, DMIX, (bf16_t*)(ws + WS_WOUT), 64 * kb, 32 * nb, 32 * nb, scr, lane); continue; }
        r -= I_OUT;
        { const int kb = r / 16, nb = r % 16;
          transpose_item(a.in[I_GLUW] + (size_t)L * 512 * 512, 512, 512, (bf16_t*)(ws + WS_WGLU), 64 * kb, 32 * nb, 32 * nb, scr, lane); }
    }
    for (int idx = blockIdx.x * 512 + tid; idx < 16384; idx += gridDim.x * 512) {
        const int n = idx >> 10, k = idx & 1023;
        ((bf16_t*)(ws + WS_WDT))[idx] = n < 8 ? f2bf(a.in[I_WIN][(size_t)L * DM * DIN + (size_t)k * DIN + 3584 + n] * a.in[I_NORMG][(size_t)(L * 6 + 2) * DM + k]) : (bf16_t)0;
    }
}

template <bool FIRST, bool DT, bool WXN>
__device__ __forceinline__ void rowpass(LAS unsigned char* lds, const float* hin, float* hout, const bf16_t* Y, float scale, const float* gpost, const float* gpre,
                                        bf16_t* XN, const float* winL, float* dtout) {
    const int tid = threadIdx.x, lane = tid & 63, w = tid >> 6;
    LAS f32x4* wd = (LAS f32x4*)lds;
    if (DT) {
        LAS float* wdf = (LAS float*)lds;
        for (int idx = tid; idx < 8192; idx += 512) { const int k = idx >> 3, c = idx & 7, l = (k & 255) >> 2, e = k & 3, j = k >> 8, half = c >> 2;
            wdf[((((j * 4 + e) * 2 + half) * 64 + l) << 2) + (c & 3)] = winL[(size_t)k * DIN + 3584 + c]; }
        __syncthreads();
    }
    f32x4 gp[4], gq[4];
#pragma unroll
    for (int j = 0; j < 4; ++j) { gp[j] = FIRST ? (f32x4){0.f, 0.f, 0.f, 0.f} : *(const f32x4*)(gpost + 4 * lane + 256 * j); gq[j] = WXN ? *(const f32x4*)(gpre + 4 * lane + 256 * j) : (f32x4){0.f, 0.f, 0.f, 0.f}; }
    for (int row = blockIdx.x * 8 + w; row < NTOK; row += gridDim.x * 8) {
        f32x4 hv[4];
#pragma unroll
        for (int j = 0; j < 4; ++j) hv[j] = *(const f32x4*)(hin + (size_t)row * DM + 4 * lane + 256 * j);
        if (!FIRST) {
            f32x4 yv[4]; float ss = 0.f;
#pragma unroll
            for (int j = 0; j < 4; ++j) { yv[j] = unpack4(*(const u32x2*)(Y + (size_t)row * DM + 4 * lane + 256 * j)); ss += (yv[j][0] * yv[j][0] + yv[j][1] * yv[j][1]) + (yv[j][2] * yv[j][2] + yv[j][3] * yv[j][3]); }
            const float rs = scale * __frsqrt_rn(wave_sum(ss) * (1.f / DM) + EPS);
#pragma unroll
            for (int j = 0; j < 4; ++j) hv[j] = hv[j] + (yv[j] * rs) * gp[j];
        }
#pragma unroll
        for (int j = 0; j < 4; ++j) *(f32x4*)(hout + (size_t)row * DM + 4 * lane + 256 * j) = hv[j];
        if (WXN) {
            float s2 = 0.f;
#pragma unroll
            for (int j = 0; j < 4; ++j) s2 += (hv[j][0] * hv[j][0] + hv[j][1] * hv[j][1]) + (hv[j][2] * hv[j][2] + hv[j][3] * hv[j][3]);
            const float r2 = __frsqrt_rn(wave_sum(s2) * (1.f / DM) + EPS);
            f32x4 xn[4];
#pragma unroll
            for (int j = 0; j < 4; ++j) { xn[j] = (hv[j] * r2) * gq[j]; *(u32x2*)(XN + (size_t)row * DM + 4 * lane + 256 * j) = pack4(xn[j]); }
            if (DT) {
                f32x4 d0 = {0.f, 0.f, 0.f, 0.f}, d1 = {0.f, 0.f, 0.f, 0.f};
#pragma unroll
                for (int j = 0; j < 4; ++j)
#pragma unroll
                    for (int e = 0; e < 4; ++e) { const float xv = xn[j][e]; d0 = d0 + wd[((j * 4 + e) * 2 + 0) * 64 + lane] * xv; d1 = d1 + wd[((j * 4 + e) * 2 + 1) * 64 + lane] * xv; }
                float o = 0.f;
#pragma unroll
                for (int c = 0; c < 4; ++c) { const float s0 = wave_sum(d0[c]), s1 = wave_sum(d1[c]); if (lane == c) o = s0; if (lane == 4 + c) o = s1; }
                if (lane < 8) dtout[(size_t)row * 8 + lane] = o;
            }
        }
    }
}


__device__ __forceinline__ void dt_pass(const bf16_t* XN, const bf16_t* WDT, const float* RS, float* dtout) {
    const int lane = threadIdx.x & 63, w = threadIdx.x >> 6, r = lane & 15, q = lane >> 4;
    for (int wt = w * gridDim.x + blockIdx.x; wt < NTOK / 16; wt += gridDim.x * 8) {
        const bf16_t* xp = XN + (size_t)(16 * wt + r) * DM + 8 * q; const bf16_t* wp = WDT + (size_t)r * DM + 8 * q;
        f32x4 acc = {0.f, 0.f, 0.f, 0.f};
#pragma unroll
        for (int kb = 0; kb < 4; ++kb) {
            bf16x8 xf[8], wf[8];
#pragma unroll
            for (int ks = 0; ks < 8; ++ks) { xf[ks] = *(const bf16x8*)(xp + 32 * (kb * 8 + ks)); wf[ks] = *(const bf16x8*)(wp + 32 * (kb * 8 + ks)); }
#pragma unroll
            for (int ks = 0; ks < 8; ++ks) acc = mma(wf[ks], xf[ks], acc);
        }
        if (q < 2) *(f32x4*)(dtout + (size_t)(16 * wt + r) * 8 + 4 * q) = acc * RS[16 * wt + r];
    }
}


__device__ __forceinline__ void r0_pass(const float* x, bf16_t* HBo, float* RS) {
    const int lane = threadIdx.x & 63, w = threadIdx.x >> 6;
    for (int row = (blockIdx.x * 8 + w) * 2; row < NTOK; row += gridDim.x * 16) {
        f32x4 hv[2][4];
#pragma unroll
        for (int rr = 0; rr < 2; ++rr)
#pragma unroll
            for (int j = 0; j < 4; ++j) hv[rr][j] = *(const f32x4*)(x + (size_t)(row + rr) * DM + 4 * lane + 256 * j);
#pragma unroll
        for (int rr = 0; rr < 2; ++rr) {
            float s2 = 0.f;
#pragma unroll
            for (int j = 0; j < 4; ++j) { s2 += (hv[rr][j][0] * hv[rr][j][0] + hv[rr][j][1] * hv[rr][j][1]) + (hv[rr][j][2] * hv[rr][j][2] + hv[rr][j][3] * hv[rr][j][3]);
                *(u32x2*)(HBo + (size_t)(row + rr) * DM + 4 * lane + 256 * j) = pack4(hv[rr][j]); }
            const float r2 = __frsqrt_rn(wave_sum(s2) * (1.f / DM) + EPS);
            if (lane == 0) RS[row + rr] = r2;
        }
    }
}

__device__ __forceinline__ void sincos_d(double x, double& s, double& c) {
    const double TWO_PI = 6.283185307179586476925286766559;
    x = x - TWO_PI * rint(x / TWO_PI);
    const double y = x * 0.125, y2 = y * y;
    double sy = y * (1.0 + y2 * (-1.0 / 6 + y2 * (1.0 / 120 + y2 * (-1.0 / 5040 + y2 * (1.0 / 362880 + y2 * (-1.0 / 39916800 + y2 * (1.0 / 6227020800.0)))))));
    double cy = 1.0 + y2 * (-0.5 + y2 * (1.0 / 24 + y2 * (-1.0 / 720 + y2 * (1.0 / 40320 + y2 * (-1.0 / 3628800 + y2 * (1.0 / 479001600.0))))));
#pragma unroll
    for (int i = 0; i < 3; ++i) { const double s2 = 2.0 * sy * cy, c2 = cy * cy - sy * sy; sy = s2; cy = c2; }
    s = sy; c = cy;
}
__device__ __forceinline__ void setup_params(const Args& a) {
    const int gt = blockIdx.x * 512 + threadIdx.x;
    unsigned char* ws = a.ws;
    if (gt < 512) { float* lb = (float*)(ws + WS_LB); const float a0 = a.in[I_LBLOG][gt], a1 = a.in[I_LBLOG][512 + gt]; lb[gt] = 0.f; lb[512 + gt] = 1.f / (1.f + expf(a0 - a1)); }
    if (gt < 4096) {
        const int L = gt >> 11, g = (gt >> 6) & 31, p = gt & 63, gi = (L * 32 + g) * 64 + p;
        unsigned char* base = ws + WS_S5P + (size_t)L * S5P_STRIDE;
        const double delta = exp((double)a.in[I_S5LDT][L * 32 + g]);
        const double ar = a.in[I_S5ARE][gi], ai = a.in[I_S5AIM][gi];
        const double mag = exp(ar * delta); double sn, cs; sincos_d(ai * delta, sn, cs);
        const double abr = mag * cs, abi = mag * sn, den = ar * ar + ai * ai, nr = abr - 1.0, ni = abi;
        const double fr = (nr * ar + ni * ai) / den, fi = (ni * ar - nr * ai) / den;
        double pr = abr, pi = abi;
#pragma unroll
        for (int i = 0; i < 6; ++i) { const double tr = pr * pr - pi * pi, ti = 2.0 * pr * pi; pr = tr; pi = ti; }
        ((f32x2*)(base + S5P_ABAR))[g * 64 + p] = (f32x2){(float)abr, (float)abi};
        ((f32x2*)(base + S5P_A64))[g * 64 + p] = (f32x2){(float)pr, (float)pi};
        bf16_t* bbp = (bf16_t*)(base + S5P_BBP); bf16_t* cm = (bf16_t*)(base + S5P_CM);
        for (int cc = 0; cc < 16; ++cc) {
            const double br = a.in[I_S5BRE][(size_t)gi * 16 + cc], bi = a.in[I_S5BIM][(size_t)gi * 16 + cc];
            bbp[(g * 128 + p) * 32 + cc] = f2bf((float)(fr * br - fi * bi)); bbp[(g * 128 + p) * 32 + 16 + cc] = 0;
            bbp[(g * 128 + 64 + p) * 32 + cc] = f2bf((float)(fr * bi + fi * br)); bbp[(g * 128 + 64 + p) * 32 + 16 + cc] = 0;
            const size_t ci = ((size_t)(L * 32 + g) * 16 + cc) * 64 + p;
            cm[(g * 16 + cc) * 128 + 2 * p] = f2bf(a.in[I_S5CRE][ci]); cm[(g * 16 + cc) * 128 + 2 * p + 1] = f2bf(-a.in[I_S5CIM][ci]);
        }
    }
}

#define RLX_AGENT __ATOMIC_RELAXED, __HIP_MEMORY_SCOPE_AGENT
#define XB_TMO      128
#define XB_XCNT(j)  (256  + 64 * (j))
#define XB_XSUB(j)  (1280 + 64 * (j))
#define XB_XGEN(j)  (2304 + 64 * (j))
#define XB_TOP      3328
#define XB_TOPGEN   3392
#define XCD_BAR_WORDS 3456
#define XB_SPIN_CAP (1u << 18)

__device__ __forceinline__ unsigned xb_ld(unsigned* p)              { return __hip_atomic_load(p, __ATOMIC_RELAXED, __HIP_MEMORY_SCOPE_AGENT); }
__device__ __forceinline__ unsigned xb_add(unsigned* p, unsigned v) { return __hip_atomic_fetch_add(p, v, __ATOMIC_RELAXED, __HIP_MEMORY_SCOPE_AGENT); }
__device__ __forceinline__ unsigned xb_xcc_id() { return (unsigned)__builtin_amdgcn_s_getreg((3 << 11) | 20) & 0xFu; }
#define XB_SPIN(cond, bar) do { unsigned _sp = 0; while (cond) { __builtin_amdgcn_s_sleep(1); \
    if ((++_sp & 255u) == 0u) { if (xb_ld(&(bar)[XB_TMO])) break; if (_sp > XB_SPIN_CAP) { atomicAdd(&(bar)[XB_TMO], 1u); break; } } } } while (0)

struct XcdBarrier {
    unsigned* bar; unsigned x;
    volatile LAS unsigned* st;
};

__device__ __forceinline__ XcdBarrier xcd_barrier_post(unsigned* bar, volatile LAS unsigned* st) {
    XcdBarrier b; b.bar = bar; b.x = xb_xcc_id(); b.st = st;
    if (threadIdx.x == 0) (void)xb_add(&bar[XB_XCNT(b.x)], 1u);
    return b;
}
__device__ __forceinline__ void xcd_barrier_complete(unsigned* bar, unsigned x, unsigned& nloc, unsigned& nx) {
    const unsigned G = gridDim.x * gridDim.y * gridDim.z;
    unsigned sum, cnt, mine, sp = 0u;
    for (;;) {
        sum = 0u; cnt = 0u; mine = 0u;
#pragma unroll
        for (unsigned j = 0; j < 16; ++j) { const unsigned c = xb_ld(&bar[XB_XCNT(j)]); sum += c; cnt += (c > 0u) ? 1u : 0u; mine = (j == x) ? c : mine; }
        if (sum == G) break;
        __builtin_amdgcn_s_sleep(1);
        if ((++sp & 255u) == 0u) { if (xb_ld(&bar[XB_TMO])) break; if (sp > XB_SPIN_CAP) { atomicAdd(&bar[XB_TMO], 1u); break; } }
    }
    nloc = mine > 0u ? mine : 1u; nx = cnt > 0u ? cnt : 1u;
}

__device__ __forceinline__ void xcd_barrier(const XcdBarrier& b) {
    asm volatile("s_waitcnt vmcnt(0)" ::: "memory");
    __syncthreads();
    if (threadIdx.x == 0) {
        unsigned* bar = b.bar;
        __builtin_amdgcn_s_waitcnt(0);
        unsigned nloc = b.st[0], nx = b.st[1];
        if (nloc == 0u) { xcd_barrier_complete(bar, b.x, nloc, nx); b.st[0] = nloc; b.st[1] = nx; }
        const unsigned old = xb_add(&bar[XB_XSUB(b.x)], 1u);
        const unsigned gen = old / nloc;
        if (old + 1u == (gen + 1u) * nloc) {
            __builtin_amdgcn_fence(__ATOMIC_RELEASE, "agent");
            asm volatile("s_waitcnt vmcnt(0)" ::: "memory");
            const unsigned og = xb_add(&bar[XB_TOP], 1u);
            const unsigned tg = og / nx;
            if (og + 1u == (tg + 1u) * nx) xb_add(&bar[XB_TOPGEN], 1u);
            else XB_SPIN(xb_ld(&bar[XB_TOPGEN]) == tg, bar);
            __builtin_amdgcn_fence(__ATOMIC_ACQUIRE, "agent");
            xb_add(&bar[XB_XGEN(b.x)], 1u);
            asm volatile("s_waitcnt vmcnt(0)" ::: "memory");
        } else {
            XB_SPIN(xb_ld(&bar[XB_XGEN(b.x)]) == gen, bar);
            __builtin_amdgcn_fence(__ATOMIC_ACQUIRE, "agent");
            asm volatile("s_waitcnt vmcnt(0)" ::: "memory");
        }
    }
    __syncthreads();
}


#ifndef DBG_HG
#define DBG_HG 0
#endif


__device__ __forceinline__ float rcpf_(float x) { return __builtin_amdgcn_rcpf(x); }
__device__ __forceinline__ float lo16f(unsigned u) { return __builtin_bit_cast(float, u << 16); }
__device__ __forceinline__ float hi16f(unsigned u) { return __builtin_bit_cast(float, u & 0xffff0000u); }

struct HgIn { unsigned fr[8], vr[8], qr[8]; };
struct HgLate { u32x4 sreg[4]; u32x4 greg[2]; };
template <int MODE>
__device__ __forceinline__ void hg_late(const Args& a, int it, HgLate& T) {
    const int tid = threadIdx.x, lane = tid & 63, w = tid >> 6, r = lane & 15, q = lane >> 4;
    const int b = it >> 9, h = (it >> 7) & 3, c = it & 127;
    if (MODE == 3) {
        const unsigned char* Pg = a.ws + WS_PROJ + (size_t)(b * 128 + c) * PT_CS + (size_t)(CT_G + h) * 16384;
        const bf16_t* Sg = (const bf16_t*)(a.ws + WS_HGS) + (size_t)it * 16384;
#pragma unroll
        for (int j = 0; j < 4; ++j) T.sreg[j] = __builtin_nontemporal_load((const u32x4*)(Sg + (size_t)(tid + 512 * j) * 8));
#pragma unroll
        for (int pi = 0; pi < 2; ++pi) T.greg[pi] = *(const u32x4*)(Pg + (16 * (w >> 1) + r) * 256 + (32 * (2 * (w & 1) + pi) + 8 * q) * 2);
    }
}
template <int MODE>
__device__ __forceinline__ void hg_load(const Args& a, int it, HgIn& R) {
    const int tid = threadIdx.x, lane = tid & 63, w = tid >> 6;
    const int b = it >> 9, h = (it >> 7) & 3, c = it & 127;
    const unsigned char* P = a.ws + WS_PROJ + (size_t)(b * 128 + c) * PT_CS + (size_t)h * 16384 + (8 * w) * 256 + 4 * lane;
#pragma unroll
    for (int j = 0; j < 8; ++j) { const unsigned char* pr = P + j * 256; R.fr[j] = *(const unsigned*)(pr + CT_F * 16384); R.vr[j] = *(const unsigned*)(pr + CT_I * 16384); if (MODE == 3) R.qr[j] = *(const unsigned*)(pr + CT_Q * 16384); }
}
template <int MODE>
__device__ __forceinline__ void hg_compute(LAS unsigned char* lds, const Args& a, int L, int it, const HgIn& R, const HgLate& T) {
    const int tid = threadIdx.x, lane = tid & 63, w = tid >> 6, r = lane & 15, q = lane >> 4;
    const int b = it >> 9, h = (it >> 7) & 3, c = it & 127;
    unsigned char* Pq = a.ws + WS_PROJ + (size_t)(b * 128 + c) * PT_CS + (size_t)(CT_Q + h) * 16384;
    LAS bf16_t* Qt = (LAS bf16_t*)(lds + 0);
    LAS bf16_t* Kt = (LAS bf16_t*)(lds + 17408);
    LAS bf16_t* Qi = (LAS bf16_t*)(lds + 34816);
    LAS bf16_t* VT = (LAS bf16_t*)(lds + 52224);
    LAS bf16_t* KsT = (LAS bf16_t*)(lds + 0);
    LAS bf16_t* Sc = (LAS bf16_t*)(lds + 70656);
    LAS float* tot = (LAS float*)(lds + 79872);
    LAS float* red = (LAS float*)(lds + 83968);
    LAS bf16_t* Ss = (LAS bf16_t*)(lds + 84480);
    const u32x4 (&sreg)[4] = T.sreg; const u32x4 (&greg)[2] = T.greg;
    const f32x2 lb2 = *(const f32x2*)((const float*)(a.ws + WS_LB) + L * 512 + h * 128 + 2 * lane);
    float cs[2][8], km[2][8], run[2] = {0.f, 0.f};
#pragma unroll
    for (int j = 0; j < 8; ++j)
#pragma unroll
        for (int c2 = 0; c2 < 2; ++c2) {
            const float z = c2 ? hi16f(R.fr[j]) : lo16f(R.fr[j]), lbk = c2 ? lb2.y : lb2.x;
            const float e = __expf(-z), sg = rcpf_(1.f + e), f = lbk + (1.f - lbk) * sg;
            km[c2][j] = (1.f - lbk) * e * sg;
            run[c2] += __log2f(f); cs[c2][j] = run[c2];
        }
    *(LAS f32x2*)(tot + w * 128 + 2 * lane) = (f32x2){run[0], run[1]};
    {
        u32x4 v0, v1;
#pragma unroll
        for (int j = 0; j < 4; ++j) { v0[j] = (R.vr[2 * j] & 0xffffu) | (R.vr[2 * j + 1] << 16); v1[j] = (R.vr[2 * j] >> 16) | (R.vr[2 * j + 1] & 0xffff0000u); }
        *(LAS u32x4*)(VT + (2 * lane) * 72 + 8 * w) = v0; *(LAS u32x4*)(VT + (2 * lane + 1) * 72 + 8 * w) = v1;
    }
    if (MODE == 3) {
#pragma unroll
        for (int j = 0; j < 4; ++j) { const int idx = tid + 512 * j; *(LAS u32x4*)(Ss + (idx >> 4) * 136 + (idx & 15) * 8) = sreg[j]; }
    }
    __syncthreads();
    float off[2] = {0.f, 0.f}, bmid[2] = {0.f, 0.f}, blast[2] = {0.f, 0.f};
#pragma unroll
    for (int s = 0; s < 8; ++s) { const f32x2 tv = *(const LAS f32x2*)(tot + s * 128 + 2 * lane);
        if (s < w) { off[0] += tv.x; off[1] += tv.y; } if (s < 4) { bmid[0] += tv.x; bmid[1] += tv.y; } blast[0] += tv.x; blast[1] += tv.y; }
    if (MODE == 1) {
        u32x4 k0, k1; float kv[2][8];
#pragma unroll
        for (int j = 0; j < 8; ++j)
#pragma unroll
            for (int c2 = 0; c2 < 2; ++c2) kv[c2][j] = km[c2][j] * __builtin_amdgcn_exp2f(blast[c2] - (cs[c2][j] + off[c2]));
#pragma unroll
        for (int j = 0; j < 4; ++j) { k0[j] = cvt_pk_bf16(kv[0][2 * j], kv[0][2 * j + 1]); k1[j] = cvt_pk_bf16(kv[1][2 * j], kv[1][2 * j + 1]); }
        *(LAS u32x4*)(KsT + (2 * lane) * 72 + 8 * w) = k0; *(LAS u32x4*)(KsT + (2 * lane + 1) * 72 + 8 * w) = k1;
        if (w == 0) *(f32x2*)((float*)(a.ws + WS_HGDEC) + (size_t)it * 128 + 2 * lane) = (f32x2){__builtin_amdgcn_exp2f(blast[0]), __builtin_amdgcn_exp2f(blast[1])};
        __syncthreads();
        f32x4 acc[8];
#pragma unroll
        for (int kt = 0; kt < 8; ++kt) acc[kt] = (f32x4){0.f, 0.f, 0.f, 0.f};
#pragma unroll
        for (int ks = 0; ks < 2; ++ks) {
            const bf16x8 pf = ldsfrag(VT, 16 * w + r, 72, 32 * ks + 8 * q);
#pragma unroll
            for (int kt = 0; kt < 8; ++kt) acc[kt] = mma(ldsfrag(KsT, 32 * (kt >> 1) + pg8::perm32(16 * (kt & 1) + r), 72, 32 * ks + 8 * q), pf, acc[kt]);
        }
        bf16_t* S = (bf16_t*)(a.ws + WS_HGS) + (size_t)it * 16384 + (size_t)(16 * w + r) * 128 + 8 * q;
#pragma unroll
        for (int kt = 0; kt < 8; kt += 2) { const u32x2 lo = pack4(acc[kt]), hi = pack4(acc[kt + 1]); __builtin_nontemporal_store((u32x4){lo.x, lo.y, hi.x, hi.y}, (u32x4*)(S + 16 * kt)); }
    } else {
#pragma unroll
        for (int j = 0; j < 8; ++j) {
            const int t = 8 * w + j; float qt2[2], qi2[2], kt2[2];
#pragma unroll
            for (int c2 = 0; c2 < 2; ++c2) {
                const float bt = cs[c2][j] + off[c2];
                const float qraw = c2 ? hi16f(R.qr[j]) : lo16f(R.qr[j]);
                const float qv = qraw * rcpf_(1.f + __expf(-qraw));
                qt2[c2] = qv * __builtin_amdgcn_exp2f(bt - bmid[c2]); qi2[c2] = qv * __builtin_amdgcn_exp2f(bt); kt2[c2] = km[c2][j] * __builtin_amdgcn_exp2f(bmid[c2] - bt);
            }
            *(LAS unsigned*)(Qt + t * 136 + 2 * lane) = cvt_pk_bf16(qt2[0], qt2[1]);
            *(LAS unsigned*)(Qi + t * 136 + 2 * lane) = cvt_pk_bf16(qi2[0], qi2[1]);
            *(LAS unsigned*)(Kt + t * 136 + 2 * lane) = cvt_pk_bf16(kt2[0], kt2[1]);
        }
        __syncthreads();
        const int tt = w >> 1;
#pragma unroll
        for (int i = 0; i < 2; ++i) {
            const int ts = 2 * (w & 1) + i; f32x4 acc = {0.f, 0.f, 0.f, 0.f};
            if (ts <= tt) {
#pragma unroll
                for (int ks = 0; ks < 4; ++ks) acc = mma(ldsfrag(Kt, 16 * ts + r, 136, 32 * ks + 8 * q), ldsfrag(Qt, 16 * tt + r, 136, 32 * ks + 8 * q), acc);
            }
            const int t = 16 * tt + r, s0 = 16 * ts + 4 * q;
#pragma unroll
            for (int jj = 0; jj < 4; ++jj) if (s0 + jj > t) acc[jj] = 0.f;
            *(LAS u32x2*)(Sc + t * 72 + s0) = pack4(acc);
        }
        __syncthreads();
        f32x4 o[4]; float ss = 0.f;
#pragma unroll
        for (int i = 0; i < 4; ++i) {
            const int vt = 4 * (w & 1) + i; f32x4 acc = {0.f, 0.f, 0.f, 0.f};
            const int vrow = 32 * (vt >> 1) + pg8::perm32(16 * (vt & 1) + r);
#pragma unroll
            for (int ks = 0; ks < 4; ++ks) acc = mma(ldsfrag(Ss, vrow, 136, 32 * ks + 8 * q), ldsfrag(Qi, 16 * tt + r, 136, 32 * ks + 8 * q), acc);
#pragma unroll
            for (int ks = 0; ks < 2; ++ks) acc = mma(ldsfrag(VT, vrow, 72, 32 * ks + 8 * q), ldsfrag(Sc, 16 * tt + r, 72, 32 * ks + 8 * q), acc);
            o[i] = acc; ss += (acc[0] * acc[0] + acc[1] * acc[1]) + (acc[2] * acc[2] + acc[3] * acc[3]);
        }
        ss += __shfl_xor(ss, 16); ss += __shfl_xor(ss, 32);
        if (q == 0) red[w * 16 + r] = ss;
        __syncthreads();
        const float rstd = __frsqrt_rn((red[w * 16 + r] + red[(w ^ 1) * 16 + r]) * (1.f / 128.f) + EPS);
        const int t = 16 * tt + r;
#pragma unroll
        for (int pi = 0; pi < 2; ++pi) {
            const int v0 = 32 * (2 * (w & 1) + pi) + 8 * q; u32x2 pk[2];
#pragma unroll
            for (int n = 0; n < 2; ++n) {
                const f32x4 gr = unpack4((u32x2){n ? greg[pi].z : greg[pi].x, n ? greg[pi].w : greg[pi].y});
                const f32x4 gn = *(const f32x4*)(a.in[I_GNORM] + L * 128 + v0 + 4 * n); f32x4 ov;
#pragma unroll
                for (int jj = 0; jj < 4; ++jj) ov[jj] = o[2 * pi + n][jj] * rstd * gn[jj] * gr[jj] * rcpf_(1.f + __expf(-gr[jj]));
                pk[n] = pack4(ov);
            }
            *(u32x4*)(Pq + t * 256 + v0 * 2) = (u32x4){pk[0].x, pk[0].y, pk[1].x, pk[1].y};
        }
    }
}
template <int MODE>
__device__ __forceinline__ void hg_phase(LAS unsigned char* lds, const Args& a, int L) {
    HgIn cur, nxt;
    int it = blockIdx.x;
    if (it < 1024) hg_load<MODE>(a, it, cur);
    bool first = true;
    for (; it < 1024; it += gridDim.x) {
        const int itn = it + gridDim.x;
        if (itn < 1024) hg_load<MODE>(a, itn, nxt);
        if (MODE == 1 || first) __syncthreads();
        first = false;
        HgLate late; hg_late<MODE>(a, it, late);
        hg_compute<MODE>(lds, a, L, it, cur, late);
        cur = nxt;
    }
}

struct SsdIn { unsigned xr[35]; float dtr; };
struct SsdLate { f32x2 cw[4], cb; u32x4 zreg[4]; u32x4 hreg[4][2]; };
__device__ __forceinline__ int ssd_xch(int ic, int g) { return ic < 256 ? g * 256 + ic : ic < 384 ? 512 + g * 128 + (ic - 256) : 768 + g * 128 + (ic - 384); }
__device__ __forceinline__ int ssd_toff(int ic, int g) { const int x = ssd_xch(ic, g); return (CT_X + (x >> 7)) * 16384 + (x & 127) * 2; }
template <int MODE>
__device__ __forceinline__ void ssd_load(const Args& a, int it, SsdIn& R) {
    const int tid = threadIdx.x, lane = tid & 63, w = tid >> 6;
    const int b = it >> 8, c = (it >> 1) & 127, g = it & 1;
    const size_t row0 = (size_t)b * SEQ + c * 64;
    const int ic = 2 * (tid & 255), th = tid >> 8;
    if (MODE == 3 || ic < 384) {
        const unsigned char* px = a.ws + WS_PROJ + (size_t)(b * 128 + c) * PT_CS + ssd_toff(ic, g) + (32 * th) * 256;
        const bool hist = !(c == 0 && th == 0);
        const unsigned char* ph = th ? px - 3 * 256 : px - PT_CS + 61 * 256;
#pragma unroll
        for (int i = 0; i < 3; ++i) R.xr[i] = hist ? *(const unsigned*)(ph + i * 256) : 0u;
#pragma unroll
        for (int i = 3; i < 35; ++i) R.xr[i] = *(const unsigned*)(px + (i - 3) * 256);
    }
    if (w < 4) R.dtr = ((const float*)(a.ws + WS_DT))[(row0 + lane) * 8 + g * 4 + w];
}
template <int MODE>
__device__ __forceinline__ void ssd_late(const Args& a, int L, int it, SsdLate& T) {
    const int tid = threadIdx.x, lane = tid & 63, w = tid >> 6, r = lane & 15, q = lane >> 4;
    const int b = it >> 8, c = (it >> 1) & 127, g = it & 1;
    const int ic = 2 * (tid & 255), xch = ssd_xch(ic, g);
#pragma unroll
    for (int j = 0; j < 4; ++j) T.cw[j] = *(const f32x2*)(a.in[I_CONVW] + L * 4096 + j * 1024 + xch);
    T.cb = *(const f32x2*)(a.in[I_CONVB] + L * 1024 + xch);
    if (MODE == 3) {
        const unsigned char* Pz = a.ws + WS_PROJ + (size_t)(b * 128 + c) * PT_CS + (size_t)(CT_Z + 2 * g) * 16384;
        const bf16_t* Hs = (const bf16_t*)(a.ws + WS_SSDS) + ((size_t)(b * 128 + c) * 8 + g * 4) * 8192;
#pragma unroll
        for (int hh = 0; hh < 4; ++hh) {
            T.zreg[hh] = *(const u32x4*)(Pz + (hh >> 1) * 16384 + (16 * (w >> 1) + r) * 256 + ((hh & 1) * 64 + 32 * (w & 1) + 8 * q) * 2);
#pragma unroll
            for (int i = 0; i < 2; ++i) T.hreg[hh][i] = __builtin_nontemporal_load((const u32x4*)(Hs + (size_t)hh * 8192 + (size_t)(tid + 512 * i) * 8));
        }
    }
}
template <int MODE>
__device__ __forceinline__ void ssd_compute(LAS unsigned char* lds, const Args& a, int L, int it, const SsdIn& R, const SsdLate& T) {
    const int tid = threadIdx.x, lane = tid & 63, w = tid >> 6, r = lane & 15, q = lane >> 4;
    const int b = it >> 8, c = (it >> 1) & 127, g = it & 1;
    const size_t row0 = (size_t)b * SEQ + c * 64;
    unsigned char* Pz = a.ws + WS_PROJ + (size_t)(b * 128 + c) * PT_CS + (size_t)(CT_Z + 2 * g) * 16384;
    LAS float* DTs = (LAS float*)(lds + 0);
    LAS float* ACS = (LAS float*)(lds + 1024);
    LAS float* red = (LAS float*)(lds + 2048);
    LAS bf16_t* Cm = (LAS bf16_t*)(lds + 4096);
    LAS bf16_t* Bm = (LAS bf16_t*)(lds + 21504);
    LAS bf16_t* XT = (LAS bf16_t*)(lds + 38912);
    LAS bf16_t* Mh = (LAS bf16_t*)(lds + 75776);
    LAS bf16_t* Hb1 = (LAS bf16_t*)(lds + 112640);
    LAS bf16_t* XdT = (LAS bf16_t*)(lds + 4096);
    LAS bf16_t* BT = (LAS bf16_t*)(lds + 40960);
    if (w < 4) {
        const int hd = L * 8 + g * 4 + w;
        const float dtr = R.dtr + a.in[I_DTB][hd];
        const float dtv = dtr > 20.f ? dtr : log1pf(__expf(dtr));
        float v = -dtv * __expf(a.in[I_ALOG][hd]);
#pragma unroll
        for (int o = 1; o < 64; o <<= 1) { const float n = __shfl_up(v, o); if (lane >= o) v += n; }
        DTs[w * 64 + lane] = dtv; ACS[w * 64 + lane] = v;
    }
    if (MODE == 1) __syncthreads();
    {
        const int ic = 2 * (tid & 255), th = tid >> 8;
        if (MODE == 3 || ic < 384) {
            const int hh = (ic >> 6) & 3;
            const float alast = MODE == 1 ? ACS[hh * 64 + 63] : 0.f;
#pragma unroll
            for (int j8 = 0; j8 < 4; ++j8) {
                float val[2][8];
#pragma unroll
                for (int jj = 0; jj < 8; ++jj) {
                    const int j = j8 * 8 + jj;
#pragma unroll
                    for (int c2 = 0; c2 < 2; ++c2) {
                        const float x3 = c2 ? hi16f(R.xr[j]) : lo16f(R.xr[j]), x2 = c2 ? hi16f(R.xr[j + 1]) : lo16f(R.xr[j + 1]);
                        const float x1 = c2 ? hi16f(R.xr[j + 2]) : lo16f(R.xr[j + 2]), x0 = c2 ? hi16f(R.xr[j + 3]) : lo16f(R.xr[j + 3]);
                        const float v = (c2 ? T.cw[0].y : T.cw[0].x) * x3 + (c2 ? T.cw[1].y : T.cw[1].x) * x2 + (c2 ? T.cw[2].y : T.cw[2].x) * x1 + (c2 ? T.cw[3].y : T.cw[3].x) * x0 + (c2 ? T.cb.y : T.cb.x);
                        val[c2][jj] = v * rcpf_(1.f + __expf(-v));
                    }
                }
                const int tb = 32 * th + 8 * j8;
                if (ic < 256) {
                    if (MODE == 1) {
#pragma unroll
                        for (int jj = 0; jj < 8; ++jj) { const float s = DTs[hh * 64 + tb + jj] * __expf(alast - ACS[hh * 64 + tb + jj]); val[0][jj] *= s; val[1][jj] *= s; }
                    }
                    LAS bf16_t* dst = (MODE == 1 ? XdT : XT) + ic * 72 + tb;
#pragma unroll
                    for (int c2 = 0; c2 < 2; ++c2)
                        *(LAS u32x4*)(dst + c2 * 72) = (u32x4){cvt_pk_bf16(val[c2][0], val[c2][1]), cvt_pk_bf16(val[c2][2], val[c2][3]), cvt_pk_bf16(val[c2][4], val[c2][5]), cvt_pk_bf16(val[c2][6], val[c2][7])};
                } else if (ic < 384) {
                    const int n = ic - 256;
                    if (MODE == 1) {
#pragma unroll
                        for (int c2 = 0; c2 < 2; ++c2)
                            *(LAS u32x4*)(BT + (n + c2) * 72 + tb) = (u32x4){cvt_pk_bf16(val[c2][0], val[c2][1]), cvt_pk_bf16(val[c2][2], val[c2][3]), cvt_pk_bf16(val[c2][4], val[c2][5]), cvt_pk_bf16(val[c2][6], val[c2][7])};
                    } else {
#pragma unroll
                        for (int jj = 0; jj < 8; ++jj) *(LAS unsigned*)(Bm + (tb + jj) * 136 + n) = cvt_pk_bf16(val[0][jj], val[1][jj]);
                    }
                } else {
                    const int n = ic - 384;
#pragma unroll
                    for (int jj = 0; jj < 8; ++jj) *(LAS unsigned*)(Cm + (tb + jj) * 136 + n) = cvt_pk_bf16(val[0][jj], val[1][jj]);
                }
            }
        }
    }
    __syncthreads();
    const size_t sbase = ((size_t)(b * 128 + c) * 8 + g * 4) * 8192;
    if (MODE == 1) {
        const int hh = w >> 1;
        f32x4 acc[2][8];
#pragma unroll
        for (int i = 0; i < 2; ++i)
#pragma unroll
            for (int nt = 0; nt < 8; ++nt) acc[i][nt] = (f32x4){0.f, 0.f, 0.f, 0.f};
#pragma unroll
        for (int ks = 0; ks < 2; ++ks) {
            bf16x8 pf[2];
#pragma unroll
            for (int i = 0; i < 2; ++i) pf[i] = ldsfrag(XdT, hh * 64 + 16 * (2 * (w & 1) + i) + r, 72, 32 * ks + 8 * q);
#pragma unroll
            for (int nt = 0; nt < 8; ++nt) { const bf16x8 bf = ldsfrag(BT, 32 * (nt >> 1) + pg8::perm32(16 * (nt & 1) + r), 72, 32 * ks + 8 * q);
#pragma unroll
                for (int i = 0; i < 2; ++i) acc[i][nt] = mma(bf, pf[i], acc[i][nt]); }
        }
        bf16_t* S = (bf16_t*)(a.ws + WS_SSDS) + sbase + (size_t)hh * 8192;
#pragma unroll
        for (int i = 0; i < 2; ++i)
#pragma unroll
            for (int nt = 0; nt < 8; nt += 2) { const u32x2 lo = pack4(acc[i][nt]), hi = pack4(acc[i][nt + 1]);
                __builtin_nontemporal_store((u32x4){lo.x, lo.y, hi.x, hi.y}, (u32x4*)(S + (size_t)(16 * (2 * (w & 1) + i) + r) * 128 + 16 * nt + 8 * q)); }
        if (tid < 4) ((float*)(a.ws + WS_SSDDEC))[(size_t)(b * 128 + c) * 8 + g * 4 + tid] = __expf(ACS[tid * 64 + 63]);
    } else {
        const int tl = w >> 1, l = 16 * tl + r;
#pragma unroll
        for (int i = 0; i < 2; ++i) {
            const int ts = 2 * (w & 1) + i; f32x4 acc = {0.f, 0.f, 0.f, 0.f};
            if (ts <= tl) {
#pragma unroll
                for (int ks = 0; ks < 4; ++ks) acc = mma(ldsfrag(Bm, 16 * ts + r, 136, 32 * ks + 8 * q), ldsfrag(Cm, 16 * tl + r, 136, 32 * ks + 8 * q), acc);
            }
            const int s0 = 16 * ts + 4 * q;
#pragma unroll
            for (int hh = 0; hh < 4; ++hh) {
                const float al = ACS[hh * 64 + l]; f32x4 mv;
#pragma unroll
                for (int jj = 0; jj < 4; ++jj) { const int s = s0 + jj; mv[jj] = (s <= l) ? acc[jj] * __expf(al - ACS[hh * 64 + s]) * DTs[hh * 64 + s] : 0.f; }
                *(LAS u32x2*)(Mh + (hh * 64 + l) * 72 + s0) = pack4(mv);
            }
        }
#pragma unroll
        for (int i = 0; i < 2; ++i) { const int idx = tid + 512 * i; *(LAS u32x4*)(Hb1 + (idx >> 4) * 136 + (idx & 15) * 8) = T.hreg[0][i]; }
        __syncthreads();
        f32x4 yr[4][2]; float ss = 0.f;
#pragma unroll
        for (int hh = 0; hh < 4; ++hh) {
            LAS bf16_t* Hc = (hh & 1) ? Bm : Hb1;
            if (hh < 3) { LAS bf16_t* Hn = (hh & 1) ? Hb1 : Bm;
#pragma unroll
                for (int i = 0; i < 2; ++i) { const int idx = tid + 512 * i; *(LAS u32x4*)(Hn + (idx >> 4) * 136 + (idx & 15) * 8) = T.hreg[hh + 1][i]; } }
            const float el = __expf(ACS[hh * 64 + l]), Dh = a.in[I_SSDD][L * 8 + g * 4 + hh];
#pragma unroll
            for (int i = 0; i < 2; ++i) {
                const int prow = 32 * (w & 1) + pg8::perm32(16 * i + r);
                f32x4 ad = {0.f, 0.f, 0.f, 0.f}, ao = {0.f, 0.f, 0.f, 0.f};
#pragma unroll
                for (int ks = 0; ks < 2; ++ks) ad = mma(ldsfrag(XT, hh * 64 + prow, 72, 32 * ks + 8 * q), ldsfrag(Mh, hh * 64 + 16 * tl + r, 72, 32 * ks + 8 * q), ad);
#pragma unroll
                for (int ks = 0; ks < 4; ++ks) ao = mma(ldsfrag(Hc, prow, 136, 32 * ks + 8 * q), ldsfrag(Cm, 16 * tl + r, 136, 32 * ks + 8 * q), ao);
                const int p0 = hh * 64 + 32 * (w & 1) + 8 * q + 4 * i;
                const f32x4 zr = unpack4((u32x2){i ? T.zreg[hh].z : T.zreg[hh].x, i ? T.zreg[hh].w : T.zreg[hh].y}); f32x4 yv;
#pragma unroll
                for (int jj = 0; jj < 4; ++jj) { const float xv = bf2f(XT[(p0 + jj) * 72 + l]); yv[jj] = (ad[jj] + ao[jj] * el + Dh * xv) * zr[jj] * rcpf_(1.f + __expf(-zr[jj])); }
                yr[hh][i] = yv; ss += (yv[0] * yv[0] + yv[1] * yv[1]) + (yv[2] * yv[2] + yv[3] * yv[3]);
            }
            if (hh < 3) __syncthreads();
        }
        ss += __shfl_xor(ss, 16); ss += __shfl_xor(ss, 32);
        if (q == 0) red[w * 16 + r] = ss;
        __syncthreads();
        const float rstd = __frsqrt_rn((red[w * 16 + r] + red[(w ^ 1) * 16 + r]) * (1.f / 256.f) + EPS);
#pragma unroll
        for (int hh = 0; hh < 4; ++hh) {
            const int p0 = hh * 64 + 32 * (w & 1) + 8 * q; u32x2 pk[2];
#pragma unroll
            for (int i = 0; i < 2; ++i) { const f32x4 nw = *(const f32x4*)(a.in[I_SSDN] + L * 512 + g * 256 + p0 + 4 * i); pk[i] = pack4(yr[hh][i] * rstd * nw); }
            *(u32x4*)(Pz + (hh >> 1) * 16384 + l * 256 + ((hh & 1) * 64 + 32 * (w & 1) + 8 * q) * 2) = (u32x4){pk[0].x, pk[0].y, pk[1].x, pk[1].y};
        }
    }
}
template <int MODE>
__device__ __forceinline__ void ssd_phase(LAS unsigned char* lds, const Args& a, int L) {
    if (MODE == 1) {
        SsdIn cur, nxt; SsdLate late;
        int it = blockIdx.x;
        if (it < 512) ssd_load<MODE>(a, it, cur);
        for (; it < 512; it += gridDim.x) {
            const int itn = it + gridDim.x;
            ssd_late<MODE>(a, L, it, late);
            if (itn < 512) ssd_load<MODE>(a, itn, nxt);
            __syncthreads();
            ssd_compute<MODE>(lds, a, L, it, cur, late);
            cur = nxt;
        }
    } else {
        bool first = true;
        for (int it = blockIdx.x; it < 512; it += gridDim.x) {
            SsdIn cur; SsdLate late;
            ssd_load<MODE>(a, it, cur);
            ssd_late<MODE>(a, L, it, late);
            if (first) __syncthreads();
            first = false;
            ssd_compute<MODE>(lds, a, L, it, cur, late);
        }
    }
}

struct S5In { bf16x8 uf[4]; u32x2 uv[4]; f32x2 x0; };
struct S5Par { bf16x8 bb[8], cmf[4]; f32x2 ab; f32x4 dv; };
template <int MODE>
__device__ __forceinline__ void s5_par(const Args& a, int L, int g, S5Par& Q) {
    const int lane = threadIdx.x & 63, r = lane & 15, q = lane >> 4;
    const unsigned char* pb = a.ws + WS_S5P + (size_t)L * S5P_STRIDE;
    Q.ab = ((const f32x2*)(pb + S5P_ABAR))[g * 64 + lane];
#pragma unroll
    for (int nt = 0; nt < 8; ++nt) Q.bb[nt] = *(const bf16x8*)((const bf16_t*)(pb + S5P_BBP) + (size_t)(g * 128 + 16 * nt + r) * 32 + 8 * q);
    if (MODE == 3) {
#pragma unroll
        for (int ks = 0; ks < 4; ++ks) Q.cmf[ks] = *(const bf16x8*)((const bf16_t*)(pb + S5P_CM) + (size_t)(g * 16 + r) * 128 + 32 * ks + 8 * q);
        Q.dv = *(const f32x4*)(a.in[I_S5D] + L * 512 + g * 16 + 4 * q);
    }
}
template <int MODE>
__device__ __forceinline__ void s5_load(const Args& a, int it, S5In& R) {
    const int tid = threadIdx.x, lane = tid & 63, w = tid >> 6, r = lane & 15, q = lane >> 4;
    const int b = it >> 9, c = (it >> 2) & 127, g = (it & 3) * 8 + w;
    const unsigned char* P = a.ws + WS_PROJ + (size_t)(b * 128 + c) * PT_CS + (size_t)(CT_U + (it & 3)) * 16384 + (w * 16) * 2;
#pragma unroll
    for (int sc = 0; sc < 4; ++sc) {
        R.uf[sc] = (bf16x8){0, 0, 0, 0, 0, 0, 0, 0};
        if (q < 2) R.uf[sc] = *(const bf16x8*)(P + (sc * 16 + r) * 256 + (8 * q) * 2);
        if (MODE == 3) R.uv[sc] = *(const u32x2*)(P + (sc * 16 + r) * 256 + (4 * q) * 2);
    }
    if (MODE == 3) R.x0 = *((const f32x2*)(a.ws + WS_S5X) + ((size_t)(b * 128 + c) * 32 + g) * 64 + lane);
}
template <int MODE>
__device__ __forceinline__ void s5_compute(LAS unsigned char* lds, const Args& a, int it, const S5In& R, const S5Par& Q) {
    const int tid = threadIdx.x, lane = tid & 63, w = tid >> 6, r = lane & 15, q = lane >> 4;
    const int b = it >> 9, c = (it >> 2) & 127, g = (it & 3) * 8 + w;
    const size_t row0 = (size_t)b * SEQ + c * 64;
    LAS float* BU = (LAS float*)(lds + w * 12800);
    LAS bf16_t* Xs = (LAS bf16_t*)(lds + w * 12800 + 8448);
    float xr = 0.f, xi = 0.f;
    if (MODE == 3) { xr = R.x0.x; xi = R.x0.y; }
#pragma unroll
    for (int sc = 0; sc < 4; ++sc) {
        const int t0 = sc * 16;
#pragma unroll
        for (int nt = 0; nt < 8; ++nt) { const f32x4 acc = mma(Q.bb[nt], R.uf[sc], (f32x4){0.f, 0.f, 0.f, 0.f}); *(LAS f32x4*)(BU + r * 132 + 16 * nt + 4 * q) = acc; }
        asm volatile("s_waitcnt lgkmcnt(0)" ::: "memory");
#pragma unroll
        for (int tt = 0; tt < 16; ++tt) {
            const float bur = BU[tt * 132 + lane], bui = BU[tt * 132 + 64 + lane];
            const float nr = Q.ab.x * xr - Q.ab.y * xi + bur, ni = Q.ab.x * xi + Q.ab.y * xr + bui;
            xr = nr; xi = ni;
            if (MODE == 3) *(LAS unsigned*)(Xs + tt * 136 + 2 * lane) = cvt_pk_bf16(xr, xi);
        }
        asm volatile("s_waitcnt lgkmcnt(0)" ::: "memory");
        if (MODE == 3) {
            f32x4 y = {0.f, 0.f, 0.f, 0.f};
#pragma unroll
            for (int ks = 0; ks < 4; ++ks) y = mma(Q.cmf[ks], ldsfrag(Xs, r, 136, 32 * ks + 8 * q), y);
            const f32x4 uv = unpack4(R.uv[sc]); f32x4 o;
#pragma unroll
            for (int jj = 0; jj < 4; ++jj) { const float yv = y[jj] + Q.dv[jj] * uv[jj]; o[jj] = yv * rcpf_(1.f + __expf(-1.5957691216057308f * (yv + 0.044715f * yv * yv * yv))); }
            *(u32x2*)(a.ws + WS_YG + (size_t)(b * 128 + c) * 65536 + (size_t)(it & 3) * 16384 + (t0 + r) * 256 + (w * 16 + 4 * q) * 2) = pack4(o);
        }
    }
    if (MODE == 1) *((f32x2*)(a.ws + WS_S5X) + ((size_t)(b * 128 + c) * 32 + g) * 64 + lane) = (f32x2){xr, xi};
}
template <int MODE>
__device__ __forceinline__ void s5_phase(LAS unsigned char* lds, const Args& a, int L) {
    S5In cur, nxt; S5Par Q;
    const int w = threadIdx.x >> 6;
    const bool gconst = (gridDim.x & 3) == 0;
    int it = blockIdx.x;
    if (it < 1024) { s5_par<MODE>(a, L, (it & 3) * 8 + w, Q); s5_load<MODE>(a, it, cur); }
    __syncthreads();
    for (; it < 1024; it += gridDim.x) {
        const int itn = it + gridDim.x;
        if (itn < 1024) s5_load<MODE>(a, itn, nxt);
        s5_compute<MODE>(lds, a, it, cur, Q);
        cur = nxt;
        if (!gconst && itn < 1024) s5_par<MODE>(a, L, (itn & 3) * 8 + w, Q);
    }
}

__device__ __forceinline__ void scan_phase(const Args& a, int L) {
    const int tid = threadIdx.x;
    if (tid < 128) {
        const int gi = blockIdx.x * 128 + tid, bh = gi >> 12, rem = gi & 4095, v = rem >> 5, k4 = (rem & 31) * 4;
        bf16_t* S = (bf16_t*)(a.ws + WS_HGS) + (size_t)bh * 128 * 16384 + (size_t)v * 128 + k4;
        const float* D = (const float*)(a.ws + WS_HGDEC) + (size_t)bh * 128 * 128 + k4;
        f32x4 st = {0.f, 0.f, 0.f, 0.f};
        for (int c0 = 0; c0 < 128; c0 += 8) {
            u32x2 loc[8]; f32x4 dc[8];
#pragma unroll
            for (int j = 0; j < 8; ++j) { loc[j] = __builtin_nontemporal_load((const u32x2*)(S + (size_t)(c0 + j) * 16384)); dc[j] = *(const f32x4*)(D + (size_t)(c0 + j) * 128); }
#pragma unroll
            for (int j = 0; j < 8; ++j) { __builtin_nontemporal_store(pack4(st), (u32x2*)(S + (size_t)(c0 + j) * 16384)); st = dc[j] * st + unpack4(loc[j]); }
        }
    } else if (tid < 256) {
        const int gi = blockIdx.x * 128 + (tid - 128), bhd = gi >> 11, b = bhd >> 3, hd = bhd & 7, rem = gi & 2047, p = rem >> 5, n4 = (rem & 31) * 4;
        bf16_t* S = (bf16_t*)(a.ws + WS_SSDS) + ((size_t)(b * 128) * 8 + hd) * 8192 + (size_t)p * 128 + n4;
        const float* D = (const float*)(a.ws + WS_SSDDEC) + (size_t)(b * 128) * 8 + hd;
        f32x4 st = {0.f, 0.f, 0.f, 0.f};
        for (int c0 = 0; c0 < 128; c0 += 8) {
            u32x2 loc[8]; float dc[8];
#pragma unroll
            for (int j = 0; j < 8; ++j) { loc[j] = __builtin_nontemporal_load((const u32x2*)(S + (size_t)(c0 + j) * 65536)); dc[j] = D[(size_t)(c0 + j) * 8]; }
#pragma unroll
            for (int j = 0; j < 8; ++j) { __builtin_nontemporal_store(pack4(st), (u32x2*)(S + (size_t)(c0 + j) * 65536)); st = st * dc[j] + unpack4(loc[j]); }
        }
    } else if (tid < 272) {
        const int gi = blockIdx.x * 16 + (tid - 256), b = gi >> 11, gp = gi & 2047;
        const f32x2 a64 = ((const f32x2*)(a.ws + WS_S5P + (size_t)L * S5P_STRIDE + S5P_A64))[gp];
        f32x2* X = (f32x2*)(a.ws + WS_S5X) + (size_t)(b * 128) * 2048 + gp;
        float xr = 0.f, xi = 0.f;
        for (int c0 = 0; c0 < 128; c0 += 8) {
            f32x2 e[8];
#pragma unroll
            for (int j = 0; j < 8; ++j) e[j] = X[(size_t)(c0 + j) * 2048];
#pragma unroll
            for (int j = 0; j < 8; ++j) { X[(size_t)(c0 + j) * 2048] = (f32x2){xr, xi}; const float nr = a64.x * xr - a64.y * xi + e[j].x, ni = a64.x * xi + a64.y * xr + e[j].y; xr = nr; xi = ni; }
        }
    }
}

#ifndef MK_MULTI
#define MK_MULTI 0
#endif
#ifndef GU_ALIGN
#define GU_ALIGN true
#endif
#ifndef WIN_ALIGN
#define WIN_ALIGN true
#endif
constexpr int PPL = 11;
constexpr int NPHASE = 1 + PPL * NLAYER - 1;
#define IN(k) (lo <= (k) && (k) < hi)
#define SEAM(k) do { if (IN(k) && IN((k) + 1)) xcd_barrier(xbar); } while (0)
template <int L, int J>
__device__ __forceinline__ void ffn_phases(LAS unsigned char* lds, const Args& a, const XcdBarrier& xbar, int lo, int hi) {
    constexpr int pb = 1 + PPL * L + 8 * J;
    constexpr bool lastL = (L + 1 == NLAYER), last = lastL && J == 1;
    unsigned char* ws = a.ws;
    bf16_t* HBc = (lastL && J == 1) ? (bf16_t*)(ws + WS_HB2) : (bf16_t*)a.out;
    if (IN(pb)) {
        pg8::Gemm g{HBc, (const bf16_t*)(ws + (J ? WS_WGU2 : WS_WGU1)), NTOK, 2 * DFF, DM, DM, DM}; pg8::StaticOrder S; S.init(NTOK, 2 * DFF, gridDim.x, blockIdx.x);
        pg8::EpiSwiGLU E{ws + WS_PROJ, HT_CS, (const float*)(ws + WS_RS)};
        pg8::gemm_phase<pg8::EpiSwiGLU, GU_ALIGN>(lds, g, S, E);
    }
    SEAM(pb);
    if (IN(pb + 1)) {
        pg8::Gemm g{(const bf16_t*)(ws + WS_PROJ), (const bf16_t*)(ws + (J ? WS_WD2 : WS_WD1)), NTOK, DM, DFF, 0, DFF, HT_CS}; pg8::StaticOrder S; S.init(NTOK, DM, gridDim.x, blockIdx.x);
        pg8::EpiNorm E{HBc, HBc, last ? a.out : nullptr, (float*)(ws + WS_RS), a.in[I_NORMG] + (size_t)(L * 6 + (J ? 5 : 1)) * DM, 0.5f, EPS, (float*)(ws + WS_XBUF), (unsigned*)(ws + WS_CNT), 4u * (3 * L + 2 * J + 1)};
        pg8::gemm_phase<pg8::EpiNorm, false, true>(lds, g, S, E);
    }
    SEAM(pb + 1);
}
template <int L>
__device__ __forceinline__ void layer_phases(LAS unsigned char* lds, const Args& a, const XcdBarrier& xbar, int lo, int hi) {
    constexpr int p0 = 1 + PPL * L;
    unsigned char* ws = a.ws;
    ffn_phases<L, 0>(lds, a, xbar, lo, hi);
    if (IN(p0 + 2)) {
        dt_pass((const bf16_t*)a.out, (const bf16_t*)(ws + WS_WDT), (const float*)(ws + WS_RS), (float*)(ws + WS_DT));
        pg8::Gemm g{(const bf16_t*)a.out, (const bf16_t*)(ws + WS_WIN), NTOK, 4096, DM, DM, DM}; pg8::StaticOrder S; S.init(NTOK, 4096, gridDim.x, blockIdx.x);
        pg8::EpiStoreTiled E{ws + WS_PROJ, PT_CS, (const float*)(ws + WS_RS)};
        pg8::gemm_phase<pg8::EpiStoreTiled, WIN_ALIGN>(lds, g, S, E);
    }
    SEAM(p0 + 2);
    if (IN(p0 + 3)) {
        if (!(a.skip & 1)) hg_phase<1>(lds, a, L);
        if (!(a.skip & 2)) ssd_phase<1>(lds, a, L);
        if (!(a.skip & 4)) s5_phase<1>(lds, a, L);
    }
    SEAM(p0 + 3);
    if (IN(p0 + 4)) scan_phase(a, L);
    SEAM(p0 + 4);
    if (IN(p0 + 5)) {
        if (!(a.skip & 1)) hg_phase<3>(lds, a, L);
        if (!(a.skip & 2)) ssd_phase<3>(lds, a, L);
        if (!(a.skip & 4)) s5_phase<3>(lds, a, L);
    }
    SEAM(p0 + 5);
    if (IN(p0 + 6)) {
        pg8::Gemm g{(const bf16_t*)(ws + WS_YG), (const bf16_t*)(ws + WS_WGLU), NTOK, 512, 512, 0, 512, 65536}; pg8::StaticOrder S; S.init(NTOK, 512, gridDim.x, blockIdx.x);
        pg8::EpiGlu E{(const bf16_t*)(ws + WS_YG), a.in[I_GLUB] + L * 512, ws + WS_PROJ, 512, PT_CS, CT_U};
        pg8::gemm_phase<pg8::EpiGlu, false, true>(lds, g, S, E);
    }
    SEAM(p0 + 6);
    if (IN(p0 + 7)) {
        pg8::Gemm g{(const bf16_t*)(ws + WS_PROJ), (const bf16_t*)(ws + WS_WOUT), NTOK, DM, DMIX, 0, DMIX, PT_CS}; pg8::StaticOrder S; S.init(NTOK, DM, gridDim.x, blockIdx.x);
        pg8::EpiNorm E{(const bf16_t*)a.out, (L + 1 == NLAYER) ? (bf16_t*)(ws + WS_HB2) : (bf16_t*)a.out, nullptr, (float*)(ws + WS_RS), a.in[I_NORMG] + (size_t)(L * 6 + 3) * DM, 1.0f, EPS, (float*)(ws + WS_XBUF), (unsigned*)(ws + WS_CNT), 4u * (3 * L + 2)};
        pg8::gemm_phase<pg8::EpiNorm, false, true>(lds, g, S, E);
    }
    SEAM(p0 + 7);
    ffn_phases<L, 1>(lds, a, xbar, lo, hi);
    if (L + 1 < NLAYER) {
        if (IN(p0 + 10)) convert_weights(lds, a, L + 1);
        SEAM(p0 + 10);
    }
}
__global__ void __launch_bounds__(512, 2) mega_fwd(Args a) {
    extern __shared__ __attribute__((aligned(16))) unsigned char lds_raw[];
    LAS unsigned char* lds = (LAS unsigned char*)lds_raw;
    cg::grid_group grid = cg::this_grid();
    const int lo = a.ph_lo, hi = a.ph_hi;
    volatile LAS unsigned* xst = (volatile LAS unsigned*)(lds + 131072);
    if (threadIdx.x < 4) xst[threadIdx.x] = 0u;
    __syncthreads();
    const XcdBarrier xbar = xcd_barrier_post((unsigned*)(a.ws + WS_BAR), xst);
    if (IN(0)) {
        setup_params(a);
        convert_weights(lds, a, 0);
        r0_pass(a.in[I_X], (bf16_t*)a.out, (float*)(a.ws + WS_RS));
    }
    if (lo < 0) { asm volatile("s_waitcnt vmcnt(0) lgkmcnt(0)" ::: "memory"); grid.sync(); }
    if (IN(0) && IN(1)) xcd_barrier(xbar);
    layer_phases<0>(lds, a, xbar, lo, hi);
    layer_phases<1>(lds, a, xbar, lo, hi);
}
#undef IN
#undef SEAM

extern "C" void kernel_launch(void* const* d_in, const int* in_sizes, int n_in, void* d_out, int out_size, void* d_ws, size_t ws_size, hipStream_t stream) {
    static int grid = 0;
    if (grid == 0) {
        int dev = 0, cus = 0, per_cu = 0;
        hipGetDevice(&dev);
        hipDeviceGetAttribute(&cus, hipDeviceAttributeMultiprocessorCount, dev);
        if (hipFuncSetAttribute((const void*)mega_fwd, hipFuncAttributeMaxDynamicSharedMemorySize, LDS_BYTES) != hipSuccess) fprintf(stderr, "kernel_launch: hipFuncSetAttribute failed\n");
        if (hipOccupancyMaxActiveBlocksPerMultiprocessor(&per_cu, (const void*)mega_fwd, 512, LDS_BYTES) != hipSuccess || per_cu < 1) { fprintf(stderr, "kernel_launch: occupancy query gives %d\n", per_cu); per_cu = 1; }
        (void)hipGetLastError();
        grid = cus;
        if (n_in != 25 || ws_size < 256 * MiB) fprintf(stderr, "kernel_launch: unexpected n_in %d / ws %zu\n", n_in, ws_size);
    }
    (void)hipMemsetAsync((unsigned char*)d_ws + WS_BAR, 0, 49152, stream);
    Args a{};
    for (int i = 0; i < 25; ++i) a.in[i] = (const float*)d_in[i];
    a.out = (float*)d_out; a.ws = (unsigned char*)d_ws;
#if MK_MULTI
    for (int p = 0; p < NPHASE; ++p) { a.ph_lo = p; a.ph_hi = p + 1; hipLaunchKernelGGL(mega_fwd, dim3(grid), dim3(512), LDS_BYTES, stream, a); }
#else
#ifndef DBG_PH_HI
#define DBG_PH_HI NPHASE
#endif
    a.ph_lo = 0; a.ph_hi = DBG_PH_HI;
    void* args[] = {&a};
    hipError_t e = hipLaunchCooperativeKernel((const void*)mega_fwd, dim3(grid), dim3(512), args, LDS_BYTES, stream);
    if (e != hipSuccess) fprintf(stderr, "cooperative launch failed: %s (grid %d)\n", hipGetErrorString(e), grid);
#ifdef PROBE_LIST
    { const int pl[] = PROBE_LIST;
      for (int p : pl) { a.ph_lo = p & 255; a.ph_hi = (p & 255) + 1; a.skip = p >> 8; hipLaunchKernelGGL(mega_fwd, dim3(grid), dim3(512), LDS_BYTES, stream, a); } }
#endif
#endif
}
```
